# Optimizing an MI355X kernel written in HIP

```python
import math
import jax
import jax.numpy as jnp
from jax import lax
import numpy as np

D_MODEL = 1024
BATCH = 8
SEQ = 4096
DEPTH = 4

HEAD_DIM = 64
CONV_CH = 256
CONV_WIDTH = 31
N_Q_HEADS = 12
N_KV_HEADS = 4
Q_PER_KV = N_Q_HEADS // N_KV_HEADS
NSA_WIDTH = N_Q_HEADS * HEAD_DIM
MIX_WIDTH = CONV_CH + NSA_WIDTH
KV_WIDTH = N_KV_HEADS * HEAD_DIM
CMP_LEN = 32
CMP_STRIDE = 16
CMP_HIDDEN = 256
SEL_BLOCK = 64
SEL_TOPK = 8
WINDOW = 512
Q_BLOCK = 64
N_BRANCH = 3
FORCED_BONUS = 1000.0
D_FF = -(-8 * D_MODEL // (3 * 256)) * 256
IN_COLS = 2 * CONV_CH + NSA_WIDTH + 6 * KV_WIDTH + N_BRANCH * N_Q_HEADS
EPS = 1e-6

kernel_name = "hymba_conformer_nsa_alibi_trunk"


def rms_norm(x, g):
    xf = x.astype(jnp.float32)
    y = xf * lax.rsqrt(jnp.mean(xf * xf, axis=-1, keepdims=True) + EPS)
    return (y * g.astype(jnp.float32)).astype(x.dtype)


def layer_norm(x, g, b):
    xf = x.astype(jnp.float32)
    mu = jnp.mean(xf, axis=-1, keepdims=True)
    var = jnp.mean(jnp.square(xf - mu), axis=-1, keepdims=True)
    y = (xf - mu) * lax.rsqrt(var + EPS)
    return (y * g.astype(jnp.float32) + b.astype(jnp.float32)).astype(x.dtype)


def alibi_slopes(n):
    def pow2_slopes(m):
        start = 2.0 ** (-8.0 / m)
        return [start ** (i + 1) for i in range(m)]
    if math.log2(n).is_integer():
        s = pow2_slopes(n)
    else:
        c = 2 ** math.floor(math.log2(n))
        s = pow2_slopes(c) + pow2_slopes(2 * c)[0::2][: n - c]
    return np.asarray(s, dtype=np.float32)


def masked_softmax(s, mask):
    s = jnp.where(mask, s.astype(jnp.float32), -jnp.inf)
    m = jnp.max(s, axis=-1, keepdims=True)
    m = jnp.where(jnp.isfinite(m), m, 0.0)
    p = jnp.exp(s - m)
    return p / jnp.maximum(jnp.sum(p, axis=-1, keepdims=True), 1e-30)


def conv_mixer(a, w_dw, b_dw, ln_g, ln_b):
    u, v = jnp.split(a, 2, axis=-1)
    y = u * jax.nn.sigmoid(v)
    y = lax.conv_general_dilated(
        y, w_dw[:, None, :], window_strides=(1,),
        padding=[(CONV_WIDTH - 1, 0)],
        dimension_numbers=("NWC", "WIO", "NWC"),
        feature_group_count=CONV_CH) + b_dw
    y = layer_norm(y, ln_g, ln_b)
    return jax.nn.silu(y)


def compress(kr, pe, w1, w2):
    b, t = kr.shape[:2]
    chunks = kr.reshape(b, t // CMP_STRIDE, CMP_STRIDE, N_KV_HEADS, HEAD_DIM)
    lo = jnp.einsum("bclgd,ldh->bcgh", chunks, w1[:CMP_STRIDE])
    hi = jnp.einsum("bclgd,ldh->bcgh", chunks, w1[CMP_STRIDE:])
    h = lo[:, :-1] + hi[:, 1:] + jnp.einsum("ld,ldh->h", pe, w1)
    return jnp.einsum("bngh,hd->bngd", jax.nn.silu(h), w2)


def nsa_attention(q, kc, vc, ks, vs, kw, vw, gates):
    b, t = q.shape[:2]
    n_cmp = kc.shape[1]
    n_sel = t // SEL_BLOCK
    k_top = min(SEL_TOPK, n_sel)
    scale = HEAD_DIM ** -0.5
    slopes = jnp.asarray(alibi_slopes(N_Q_HEADS)).reshape(N_KV_HEADS, Q_PER_KV)[None, :, :, None, None]
    cmp_idx = jnp.arange(n_cmp)
    cmp_start = cmp_idx * CMP_STRIDE
    cmp_center = cmp_start.astype(jnp.float32) + 0.5 * (CMP_LEN - 1)
    cmp_end = cmp_start + CMP_LEN - 1
    sel_start = jnp.arange(n_sel) * SEL_BLOCK
    overlap = ((cmp_start[:, None] < sel_start[None, :] + SEL_BLOCK)
               & (cmp_start[:, None] + CMP_LEN > sel_start[None, :])).astype(jnp.float32)
    ks_blk = ks.reshape(b, n_sel, SEL_BLOCK, N_KV_HEADS, HEAD_DIM).transpose(0, 3, 1, 2, 4)
    vs_blk = vs.reshape(b, n_sel, SEL_BLOCK, N_KV_HEADS, HEAD_DIM).transpose(0, 3, 1, 2, 4)
    pad = ((0, 0), (WINDOW, 0), (0, 0), (0, 0))
    kw_pad = jnp.pad(kw, pad)
    vw_pad = jnp.pad(vw, pad)
    b_idx = jnp.arange(b)[:, None, None, None]
    g_idx = jnp.arange(N_KV_HEADS)[None, :, None, None]
    offs = jnp.arange(SEL_BLOCK)
    win_offs = jnp.arange(WINDOW + Q_BLOCK) - WINDOW
    sel_j = jnp.arange(n_sel)

    def block(i):
        t0 = i * Q_BLOCK
        tq = t0 + jnp.arange(Q_BLOCK)
        tqf = tq.astype(jnp.float32)
        qb = lax.dynamic_slice_in_dim(q, t0, Q_BLOCK, axis=1) * scale
        gb = lax.dynamic_slice_in_dim(gates, t0, Q_BLOCK, axis=1)

        s_c = jnp.einsum("bqgrd,bngd->bgrqn", qb, kc) - slopes * (tqf[:, None] - cmp_center[None, :])
        p_c = masked_softmax(s_c, cmp_end[None, :] <= tq[:, None])
        o_c = jnp.einsum("bgrqn,bngd->bqgrd", p_c, vc)

        imp = jnp.einsum("bgrqn,nj->bgqj", p_c, overlap)
        cur = tq // SEL_BLOCK
        forced = ((sel_j[None, :] == 0) | (sel_j[None, :] == cur[:, None])
                  | (sel_j[None, :] == cur[:, None] - 1))
        imp = jnp.where(sel_j[None, :] <= cur[:, None],
                        imp + FORCED_BONUS * forced.astype(jnp.float32), -jnp.inf)
        top_s, top_i = lax.top_k(imp, k_top)

        kg = ks_blk[b_idx, g_idx, top_i]
        vg = vs_blk[b_idx, g_idx, top_i]
        pos = top_i[..., None] * SEL_BLOCK + offs
        mask_s = jnp.isfinite(top_s)[..., None] & (pos <= tq[None, None, :, None, None])
        dist_s = (tqf[None, None, :, None, None] - pos.astype(jnp.float32))[:, :, None]
        s_s = jnp.einsum("bqgrd,bgqksd->bgrqks", qb, kg) - slopes[..., None] * dist_s
        s_s = s_s.reshape(b, N_KV_HEADS, Q_PER_KV, Q_BLOCK, k_top * SEL_BLOCK)
        p_s = masked_softmax(s_s, mask_s.reshape(b, N_KV_HEADS, 1, Q_BLOCK, k_top * SEL_BLOCK))
        o_s = jnp.einsum("bgrqs,bgqsd->bqgrd", p_s,
                         vg.reshape(b, N_KV_HEADS, Q_BLOCK, k_top * SEL_BLOCK, HEAD_DIM))

        kwb = lax.dynamic_slice_in_dim(kw_pad, t0, WINDOW + Q_BLOCK, axis=1)
        vwb = lax.dynamic_slice_in_dim(vw_pad, t0, WINDOW + Q_BLOCK, axis=1)
        pos_w = t0 + win_offs
        dist_w = tq[:, None] - pos_w[None, :]
        mask_w = (dist_w >= 0) & (dist_w < WINDOW) & (pos_w[None, :] >= 0)
        s_w = jnp.einsum("bqgrd,bkgd->bgrqk", qb, kwb) - slopes * dist_w.astype(jnp.float32)
        p_w = masked_softmax(s_w, mask_w)
        o_w = jnp.einsum("bgrqk,bkgd->bqgrd", p_w, vwb)

        out = gb[..., 0:1] * o_c + gb[..., 1:2] * o_s + gb[..., 2:3] * o_w
        return out.astype(q.dtype)

    outs = lax.map(block, jnp.arange(t // Q_BLOCK))
    return jnp.moveaxis(outs, 0, 1).reshape(b, t, NSA_WIDTH)


def hybrid_layer(x, attn_norm, w_in, conv_w, conv_b, conv_ln_g, conv_ln_b,
                 cmp_k_pe, cmp_k_w1, cmp_k_w2, cmp_v_pe, cmp_v_w1, cmp_v_w2,
                 w_out, ffn_norm, w_gate_up, w_down):
    b, t, _ = x.shape
    h = rms_norm(x, attn_norm)
    z = h @ w_in
    splits = np.cumsum([2 * CONV_CH, NSA_WIDTH] + [KV_WIDTH] * 6).tolist()
    a_conv, q, kc_r, vc_r, ks, vs, kw, vw, g = jnp.split(z, splits, axis=-1)
    kv_shape = (b, t, N_KV_HEADS, HEAD_DIM)
    conv_out = conv_mixer(a_conv, conv_w, conv_b, conv_ln_g, conv_ln_b)
    kc = compress(kc_r.reshape(kv_shape), cmp_k_pe, cmp_k_w1, cmp_k_w2)
    vc = compress(vc_r.reshape(kv_shape), cmp_v_pe, cmp_v_w1, cmp_v_w2)
    gates = jax.nn.sigmoid(g).reshape(b, t, N_KV_HEADS, Q_PER_KV, N_BRANCH)
    nsa_out = nsa_attention(q.reshape(b, t, N_KV_HEADS, Q_PER_KV, HEAD_DIM), kc, vc,
                            ks.reshape(kv_shape), vs.reshape(kv_shape),
                            kw.reshape(kv_shape), vw.reshape(kv_shape), gates)
    mix = jnp.concatenate([conv_out, nsa_out.astype(conv_out.dtype)], axis=-1)
    x = x + mix @ w_out
    h = rms_norm(x, ffn_norm)
    gu = h @ w_gate_up
    gate, up = jnp.split(gu, 2, axis=-1)
    return x + (jax.nn.silu(gate) * up) @ w_down


def setup_inputs(seed: int = 0) -> dict:
    key = jax.random.key(seed)
    ks = jax.random.split(key, 20)
    f32 = jnp.float32

    def nrm(k, shape, scale):
        return jax.random.normal(k, shape, f32) * scale

    return {
        "x": nrm(ks[0], (BATCH, SEQ, D_MODEL), 1.0),
        "attn_norm": 1.0 + nrm(ks[1], (DEPTH, D_MODEL), 0.05),
        "w_in": nrm(ks[2], (DEPTH, D_MODEL, IN_COLS), D_MODEL ** -0.5),
        "conv_w": nrm(ks[3], (DEPTH, CONV_WIDTH, CONV_CH), CONV_WIDTH ** -0.5),
        "conv_b": nrm(ks[4], (DEPTH, CONV_CH), 0.01),
        "conv_ln_g": 1.0 + nrm(ks[5], (DEPTH, CONV_CH), 0.05),
        "conv_ln_b": nrm(ks[6], (DEPTH, CONV_CH), 0.01),
        "cmp_k_pe": nrm(ks[7], (DEPTH, CMP_LEN, HEAD_DIM), 0.1),
        "cmp_k_w1": nrm(ks[8], (DEPTH, CMP_LEN, HEAD_DIM, CMP_HIDDEN), (CMP_LEN * HEAD_DIM) ** -0.5),
        "cmp_k_w2": nrm(ks[9], (DEPTH, CMP_HIDDEN, HEAD_DIM), CMP_HIDDEN ** -0.5),
        "cmp_v_pe": nrm(ks[10], (DEPTH, CMP_LEN, HEAD_DIM), 0.1),
        "cmp_v_w1": nrm(ks[11], (DEPTH, CMP_LEN, HEAD_DIM, CMP_HIDDEN), (CMP_LEN * HEAD_DIM) ** -0.5),
        "cmp_v_w2": nrm(ks[12], (DEPTH, CMP_HIDDEN, HEAD_DIM), CMP_HIDDEN ** -0.5),
        "w_out": nrm(ks[13], (DEPTH, MIX_WIDTH, D_MODEL), MIX_WIDTH ** -0.5),
        "ffn_norm": 1.0 + nrm(ks[14], (DEPTH, D_MODEL), 0.05),
        "w_gate_up": nrm(ks[15], (DEPTH, D_MODEL, 2 * D_FF), D_MODEL ** -0.5),
        "w_down": nrm(ks[16], (DEPTH, D_FF, D_MODEL), D_FF ** -0.5),
        "final_norm": 1.0 + nrm(ks[17], (D_MODEL,), 0.05),
    }


def reference(x, attn_norm, w_in, conv_w, conv_b, conv_ln_g, conv_ln_b,
              cmp_k_pe, cmp_k_w1, cmp_k_w2, cmp_v_pe, cmp_v_w1, cmp_v_w2,
              w_out, ffn_norm, w_gate_up, w_down, final_norm):
    for l in range(DEPTH):
        x = hybrid_layer(x, attn_norm[l], w_in[l], conv_w[l], conv_b[l], conv_ln_g[l], conv_ln_b[l],
                         cmp_k_pe[l], cmp_k_w1[l], cmp_k_w2[l], cmp_v_pe[l], cmp_v_w1[l], cmp_v_w2[l],
                         w_out[l], ffn_norm[l], w_gate_up[l], w_down[l])
    return rms_norm(x, final_norm)
```

```cpp
#include <hip/hip_runtime.h>
#include <hip/hip_cooperative_groups.h>
#include <cstdio>
#include <cstdint>
namespace cg = cooperative_groups;
__device__ __forceinline__ int my_tid() { int t = threadIdx.x; asm volatile("" : "+v"(t)); return t; }
namespace pg8 {
#define PG8_LAS __attribute__((address_space(3)))
typedef unsigned short bf16_t;
typedef short bf16x8 __attribute__((ext_vector_type(8)));
typedef float f32x4 __attribute__((ext_vector_type(4)));
typedef unsigned u32x4 __attribute__((ext_vector_type(4)));
constexpr int BM = 256, BK = 64, HALF = 128, HTB = HALF * BK * 2  , STAGE_BYTES = 8 * HTB, NXCD = 8, WGM = 8;

__host__ __device__ __forceinline__ int lds_byte(int r, int c) { const int st = (r >> 4) * 2 + (c >> 5), rr = r & 15, cc = c & 31, ob = rr * 64 + cc * 2; return st * 1024 + (ob ^ (((ob >> 9) & 1) << 5)); }
__host__ __device__ __forceinline__ void stage_rc(int b, int& R, int& C) { const int st = b / 1024, sb = b % 1024, swz = sb ^ (((sb >> 9) & 1) << 5); R = (st >> 1) * 16 + swz / 64; C = (st & 1) * 32 + (swz % 64) / 2; }
__host__ __device__ __forceinline__ int perm32(int rho) { const int n = rho >> 4, i = rho & 15; return 8 * (i >> 2) + 4 * n + (i & 3); }

struct Unit { int pm, pn, idx; };
struct Gemm { const bf16_t* A; const bf16_t* Bt; int M, N, K; };

struct StaticOrder {
    int nM, nN, nwg, G, c;
    __host__ __device__ void init(int M, int N, int G_, int c_) { nM = M / BM; nN = N / BM; nwg = nM * nN; G = G_; c = c_; }
    __host__ __device__ bool next(int i, Unit& u) const {
        const long L = (long)i * G + c; if (L >= nwg) return false;
        int wgid = (int)L; { const int q = nwg / NXCD, r = nwg % NXCD, xcd = wgid % NXCD, off = wgid / NXCD; wgid = (xcd < r ? xcd * (q + 1) : r * (q + 1) + (xcd - r) * q) + off; }
        const int nig = WGM * nN, gid = wgid / nig, fm = gid * WGM, gsz = (nM - fm) < WGM ? (nM - fm) : WGM;
        u.pm = fm + ((wgid % nig) % gsz); u.pn = (wgid % nig) / gsz; u.idx = i; return true;
    }
    __device__ __forceinline__ void a_ready(const Unit&) const {}
    __device__ __forceinline__ void done(const Unit&) const {}
};
typedef float f32x2_cvt __attribute__((ext_vector_type(2))); typedef __bf16 bf16x2_cvt __attribute__((ext_vector_type(2)));
__device__ __forceinline__ unsigned cvt_pk_bf16(float lo, float hi) { const f32x2_cvt v = {lo, hi}; const bf16x2_cvt b = __builtin_convertvector(v, bf16x2_cvt); return __builtin_bit_cast(unsigned, b); }
__device__ __forceinline__ float fast_sigmoid(float x) { return __builtin_amdgcn_rcpf(1.0f + __expf(-x)); }
__device__ __forceinline__ float fast_silu(float x) { return x * fast_sigmoid(x); }
constexpr float QSCALE2 = 0.125f * 1.4426950408889634f;

__device__ __forceinline__ float row_sumsq(const float* RSQ, int row) {
    const f32x4* p = (const f32x4*)(RSQ + (size_t)row * 16);
    const f32x4 a = p[0], b = p[1], c = p[2], d = p[3];
    const f32x4 t = (a + b) + (c + d);
    return (t[0] + t[1]) + (t[2] + t[3]);
}
__device__ __forceinline__ float row_rstd(const float* RSQ, int row) { return __builtin_amdgcn_rsqf(row_sumsq(RSQ, row) * (1.0f / 1024.0f) + 1e-6f); }
__device__ __forceinline__ float row_rstd4(const float* RSQ, int row, int fq) {
    const f32x4 a = *((const f32x4*)(RSQ + (size_t)row * 16) + fq);
    float t = (a[0] + a[1]) + (a[2] + a[3]);
    t += __shfl_xor(t, 16); t += __shfl_xor(t, 32);
    return __builtin_amdgcn_rsqf(t * (1.0f / 1024.0f) + 1e-6f);
}
struct EpiWin {
    static constexpr bool PERM = true, AFTER_DRAIN = false;
    bf16_t *ACONV, *Q, *KCR, *VCR, *KS, *KW; float* G; const PG8_LAS float* RS;
    __device__ __forceinline__ void operator()(const f32x4 (&acc)[2][2][4][2], const Unit& u, int wr, int wc, int fr, int fq) const {
        const int pn = u.pn;
        const int R0 = u.pm * BM + wr * 64 + fr, c0 = wc * 32 + 8 * fq;
        if (pn == 9) {
#pragma unroll
            for (int ai = 0; ai < 2; ++ai)
#pragma unroll
                for (int m = 0; m < 4; ++m) {
                    const float rs = RS[u.idx * 256 + wr * 64 + fr + ai * HALF + m * 16];
                    if (c0 < 36) {
                        float* gp = G + (size_t)(R0 + ai * HALF + m * 16) * 36 + c0;
                        const f32x4 v0 = acc[ai][0][m][0] * rs, v1 = acc[ai][0][m][1] * rs;
#pragma unroll
                        for (int e = 0; e < 4; ++e) { gp[e] = fast_sigmoid(v0[e]); if (c0 + 4 + e < 36) gp[4 + e] = fast_sigmoid(v1[e]); }
                    }
                }
            return;
        }
        bf16_t* P0; int SA, SM, SB; float sc = 1.0f;
        if (pn < 2) { P0 = ACONV + (size_t)R0 * 512 + pn * 256 + c0; SA = 128 * 512; SM = 16 * 512; SB = 128; }
        else if (pn < 5) { P0 = Q + (size_t)R0 * 768 + (pn - 2) * 256 + c0; SA = 128 * 768; SM = 16 * 768; SB = 128; sc = QSCALE2; }
        else if (pn < 7) { P0 = (pn == 5 ? KCR : VCR) + (size_t)(R0 >> 4) * 4096 + (R0 & 15) * 64 + (c0 >> 6) * 1024 + (c0 & 63); SA = 8 * 4096; SM = 4096; SB = 2 * 1024; }
        else { P0 = (pn == 7 ? KS : KW) + (size_t)(R0 >> 12) * (4 * 4096 * 64) + (size_t)(R0 & 4095) * 64 + (size_t)(c0 >> 6) * (4096 * 64) + (c0 & 63); SA = 128 * 64; SM = 16 * 64; SB = 2 * 4096 * 64; }
#pragma unroll
        for (int ai = 0; ai < 2; ++ai)
#pragma unroll
            for (int m = 0; m < 4; ++m) {
                const float rs = RS[u.idx * 256 + wr * 64 + fr + ai * HALF + m * 16] * sc;
#pragma unroll
                for (int bj = 0; bj < 2; ++bj) {
                    const f32x4 v0 = acc[ai][bj][m][0] * rs, v1 = acc[ai][bj][m][1] * rs;
                    u32x4 w; w.x = cvt_pk_bf16(v0[0], v0[1]); w.y = cvt_pk_bf16(v0[2], v0[3]); w.z = cvt_pk_bf16(v1[0], v1[1]); w.w = cvt_pk_bf16(v1[2], v1[3]);
                    *(u32x4*)(P0 + (size_t)ai * SA + (size_t)m * SM + (size_t)bj * SB) = w;
                }
            }
    }
};
struct EpiVT {
    static constexpr bool PERM = false, AFTER_DRAIN = false;
    bf16_t *VST, *VWT; const PG8_LAS float* RS;
    __device__ __forceinline__ void operator()(const f32x4 (&acc)[2][2][4][2], const Unit& u, int wr, int wc, int fr, int fq) const {
        bf16_t* base = u.pn == 0 ? VST : VWT;
#pragma unroll
        for (int ai = 0; ai < 2; ++ai)
#pragma unroll
            for (int m = 0; m < 4; ++m) {
                const int row = u.pm * BM + ai * HALF + wr * 64 + m * 16 + 4 * fq;
                const int b = row >> 12, t = row & 4095;
                const f32x4 rs4 = *(const PG8_LAS f32x4*)(RS + u.idx * 256 + ai * HALF + wr * 64 + m * 16 + 4 * fq);
#pragma unroll
                for (int bj = 0; bj < 2; ++bj)
#pragma unroll
                    for (int n = 0; n < 2; ++n) {
                        const int col = bj * HALF + wc * 32 + n * 16 + fr, g = col >> 6, d = col & 63;
                        const f32x4 v = acc[ai][bj][m][n] * rs4;
                        unsigned long long w = (unsigned long long)cvt_pk_bf16(v[0], v[1]) | ((unsigned long long)cvt_pk_bf16(v[2], v[3]) << 32);
                        *(unsigned long long*)(base + ((size_t)(b * 4 + g) * 64 + d) * 4096 + t) = w;
                    }
            }
    }
};
struct EpiRes {
    static constexpr bool PERM = false, AFTER_DRAIN = false;
    bf16_t* XB; float* RSQ;
    __device__ __forceinline__ void operator()(const f32x4 (&acc)[2][2][4][2], const Unit& u, int wr, int wc, int fr, int fq) const {
#pragma unroll
        for (int ai = 0; ai < 2; ++ai)
#pragma unroll
            for (int m = 0; m < 4; ++m) {
                const int row = u.pm * BM + ai * HALF + wr * 64 + m * 16 + fr;
                bf16_t* xp = XB + (size_t)row * 1024 + u.pn * BM + wc * 32 + 4 * fq;
                unsigned long long b[2][2];
#pragma unroll
                for (int bj = 0; bj < 2; ++bj)
#pragma unroll
                    for (int n = 0; n < 2; ++n) b[bj][n] = *(const unsigned long long*)(xp + bj * HALF + n * 16);
                float ss = 0.f;
#pragma unroll
                for (int bj = 0; bj < 2; ++bj)
#pragma unroll
                    for (int n = 0; n < 2; ++n) {
                        const unsigned lo = (unsigned)b[bj][n], hi = (unsigned)(b[bj][n] >> 32);
                        f32x4 v = acc[ai][bj][m][n];
                        v[0] += __builtin_bit_cast(float, lo << 16); v[1] += __builtin_bit_cast(float, lo & 0xffff0000u);
                        v[2] += __builtin_bit_cast(float, hi << 16); v[3] += __builtin_bit_cast(float, hi & 0xffff0000u);
                        ss += (v[0] * v[0] + v[1] * v[1]) + (v[2] * v[2] + v[3] * v[3]);
                        *(unsigned long long*)(xp + bj * HALF + n * 16) = (unsigned long long)cvt_pk_bf16(v[0], v[1]) | ((unsigned long long)cvt_pk_bf16(v[2], v[3]) << 32);
                    }
                ss += __shfl_xor(ss, 16); ss += __shfl_xor(ss, 32);
                if (fq == 0) RSQ[(size_t)row * 16 + u.pn * 4 + wc] = ss;
            }
    }
};
struct EpiSwiglu {
    static constexpr bool PERM = true, AFTER_DRAIN = false;
    bf16_t* H; const PG8_LAS float* RS;
    __device__ __forceinline__ void operator()(const f32x4 (&acc)[2][2][4][2], const Unit& u, int wr, int wc, int fr, int fq) const {
#pragma unroll
        for (int ai = 0; ai < 2; ++ai)
#pragma unroll
            for (int m = 0; m < 4; ++m) {
                const int row = u.pm * BM + ai * HALF + wr * 64 + m * 16 + fr;
                const float rs = RS[u.idx * 256 + ai * HALF + wr * 64 + m * 16 + fr];
                const f32x4 g0 = acc[ai][0][m][0] * rs, g1 = acc[ai][0][m][1] * rs, u0 = acc[ai][1][m][0] * rs, u1 = acc[ai][1][m][1] * rs;
                float r[8];
#pragma unroll
                for (int e = 0; e < 4; ++e) { r[e] = fast_silu(g0[e]) * u0[e]; r[4 + e] = fast_silu(g1[e]) * u1[e]; }
                u32x4 w; w.x = cvt_pk_bf16(r[0], r[1]); w.y = cvt_pk_bf16(r[2], r[3]); w.z = cvt_pk_bf16(r[4], r[5]); w.w = cvt_pk_bf16(r[6], r[7]);
                *(u32x4*)(H + (size_t)row * 2816 + u.pn * 128 + wc * 32 + 8 * fq) = w;
            }
    }
};
struct EpiCmp {
    static constexpr bool PERM = false, AFTER_DRAIN = false;
    float* LOHI;
    __device__ __forceinline__ void operator()(const f32x4 (&acc)[2][2][4][2], const Unit& u, int wr, int wc, int fr, int fq) const {
#pragma unroll
        for (int ai = 0; ai < 2; ++ai)
#pragma unroll
            for (int m = 0; m < 4; ++m) {
                const size_t off = (size_t)(u.pm * BM + ai * HALF + wr * 64 + m * 16 + fr) * 512 + (u.pn & 1) * BM + wc * 32 + 4 * fq;
#pragma unroll
                for (int bj = 0; bj < 2; ++bj)
#pragma unroll
                    for (int n = 0; n < 2; ++n) *(f32x4*)(LOHI + off + bj * HALF + n * 16) = acc[ai][bj][m][n];
            }
    }
};
template <class Sched>
__device__ __forceinline__ void prep_rstd(const Sched& S, const float* RSQ, PG8_LAS float* RS, int tid) {
    Unit u;
    for (int i = 0; S.next(i, u); ++i)
        if ((tid >> 8) == (i & 1)) RS[i * 256 + (tid & 255)] = row_rstd(RSQ, u.pm * BM + (tid & 255));
    __syncthreads();
}
struct CmpOrder {
    int G, c;
    __device__ bool next(int i, Unit& u) const {
        u.idx = i;
        if (G == 256) {
            if (i > 0 || (c >> 3) >= 16) return false;
            const int b = c & 7, q = c >> 3, kv = q >> 3; u.pm = kv * 32 + b * 4 + ((q >> 1) & 3); u.pn = kv * 2 + (q & 1); return true;
        }
        const long L = (long)i * G + c; if (L >= 128) return false; u.pm = (int)(L >> 1); u.pn = ((u.pm >= 32) ? 2 : 0) + (int)(L & 1); return true; }
    __device__ __forceinline__ void a_ready(const Unit&) const {}
    __device__ __forceinline__ void done(const Unit&) const {}
};
template <class Epi, class Sched, bool ALIGN_EPI = false, bool SP2 = false, bool SWAP = false>
__device__ __forceinline__ void gemm_phase(PG8_LAS unsigned char* lds, const Gemm g, const Sched& S, const Epi& E) {
    const int tid = my_tid(), wid = __builtin_amdgcn_readfirstlane(tid >> 6), lane = tid & 63, wr = wid >> 2, wc = wid & 3, fr = lane & 15, fq = lane >> 4;
    const int K = g.K, nt = K / BK;
    unsigned voffA[2], voffB[2];
#pragma unroll
    for (int i = 0; i < 2; ++i) { int R, C; stage_rc(tid * 16 + i * 8192, R, C); const int Rb = Epi::PERM ? ((R & ~31) + perm32(R & 31)) : R;
        voffA[i] = (unsigned)(R * K + C) * 2u; voffB[i] = (unsigned)(Rb * K + C) * 2u; }
    const size_t kstep = (size_t)(BK * 2);
    const size_t hstep = (size_t)HALF * K * 2;
    const size_t tstep = 2 * hstep;
    const unsigned ldsw = (unsigned)wid * 1024u;
    const int aoff = lds_byte(wr * 64 + fr, fq * 8), boff = lds_byte(wc * 32 + fr, fq * 8);
#define PG8_SA(b, h) (((b) * 2 + (h)) * HTB)
#define PG8_SB(b, h) ((4 + (b) * 2 + (h)) * HTB)
#define PG8_STAGE(bufoff, gbase, voff) do { _Pragma("unroll") for (int _i = 0; _i < 2; ++_i) \
        __builtin_amdgcn_global_load_lds((const unsigned*)((const char*)(gbase) + (voff)[_i]), (PG8_LAS unsigned*)(lds + (bufoff) + ldsw + _i * 8192), 16, 0, 0); } while (0)
#define PG8_LDA(dst, b, h) do { _Pragma("unroll") for (int m = 0; m < 4; ++m) _Pragma("unroll") for (int k = 0; k < 2; ++k) dst[m][k] = *(const PG8_LAS bf16x8*)(lds + PG8_SA(b, h) + aoff + m * 2048 + k * 1024); } while (0)
#define PG8_LDB(dst, b, h) do { _Pragma("unroll") for (int n = 0; n < 2; ++n) _Pragma("unroll") for (int k = 0; k < 2; ++k) dst[n][k] = *(const PG8_LAS bf16x8*)(lds + PG8_SB(b, h) + boff + n * 2048 + k * 1024); } while (0)
#define PG8_MMA(ai, bj, At, Bt) do { __builtin_amdgcn_s_setprio(1); _Pragma("unroll") for (int m = 0; m < 4; ++m) _Pragma("unroll") for (int n = 0; n < 2; ++n) _Pragma("unroll") for (int k = 0; k < 2; ++k) \
        acc[ai][bj][m][n] = SWAP ? __builtin_amdgcn_mfma_f32_16x16x32_bf16(At[m][k], Bt[n][k], acc[ai][bj][m][n], 0, 0, 0) : __builtin_amdgcn_mfma_f32_16x16x32_bf16(Bt[n][k], At[m][k], acc[ai][bj][m][n], 0, 0, 0); __builtin_amdgcn_s_setprio(0); } while (0)
#define PG8_WAIT_V(n) asm volatile("s_waitcnt vmcnt(" #n ")" ::: "memory")
#define PG8_WAIT_L(n) asm volatile("s_waitcnt lgkmcnt(" #n ")" ::: "memory")
#define PG8_BAR __builtin_amdgcn_s_barrier()
#define PG8_SCHED __builtin_amdgcn_sched_barrier(0)
    Unit cur, nxt; int ui = 0;
    if (!S.next(0, cur)) return;
    f32x4 acc[2][2][4][2];
#pragma unroll
    for (int a = 0; a < 2; ++a)
#pragma unroll
        for (int b = 0; b < 2; ++b)
#pragma unroll
            for (int m = 0; m < 4; ++m)
#pragma unroll
                for (int n = 0; n < 2; ++n) acc[a][b][m][n] = (f32x4){0.f, 0.f, 0.f, 0.f};
    bf16x8 At[4][2], B0[2][2], B1[2][2];
    const char* cA = (const char*)g.A + (size_t)cur.pm * tstep; const char* cB = (const char*)g.Bt + (size_t)cur.pn * tstep;
    S.a_ready(cur);
    if constexpr (SP2) {
        PG8_STAGE(PG8_SB(0, 0), cB, voffB); PG8_STAGE(PG8_SB(0, 1), cB + hstep, voffB); PG8_STAGE(PG8_SA(0, 0), cA, voffA); PG8_STAGE(PG8_SA(0, 1), cA + hstep, voffA);
        if (wr == 1) PG8_BAR;
        PG8_WAIT_V(2); PG8_BAR;
        PG8_STAGE(PG8_SB(1, 0), cB + kstep, voffB); PG8_STAGE(PG8_SA(1, 0), cA + kstep, voffA); PG8_STAGE(PG8_SB(1, 1), cB + hstep + kstep, voffB);
        PG8_WAIT_V(6); PG8_BAR;
    } else {
        PG8_STAGE(PG8_SB(0, 0), cB, voffB); PG8_STAGE(PG8_SA(0, 0), cA, voffA); PG8_STAGE(PG8_SB(0, 1), cB + hstep, voffB); PG8_STAGE(PG8_SA(0, 1), cA + hstep, voffA);
        if (wr == 1) PG8_BAR;
        PG8_WAIT_V(4); PG8_BAR;
        PG8_STAGE(PG8_SB(1, 0), cB + kstep, voffB); PG8_STAGE(PG8_SA(1, 0), cA + kstep, voffA); PG8_STAGE(PG8_SB(1, 1), cB + hstep + kstep, voffB);
        PG8_WAIT_V(6); PG8_BAR;
    }
    for (;;) {
        const bool has_next = S.next(ui + 1, nxt);
        const char* nA = has_next ? (const char*)g.A + (size_t)nxt.pm * tstep : cA; const char* nB = has_next ? (const char*)g.Bt + (size_t)nxt.pn * tstep : cB;
        for (int t = 0; t < nt; t += 2) {
            const bool last = (t == nt - 2);
            const char* a1 = cA + (size_t)(t + 1) * kstep;
            const char* a2 = last ? nA : cA + (size_t)(t + 2) * kstep; const char* b2 = last ? nB : cB + (size_t)(t + 2) * kstep;
            const char* a3 = a2 + kstep; const char* b3 = b2 + kstep;
            if (last && has_next) S.a_ready(nxt);
            if constexpr (SP2) {
            PG8_LDB(B0, 0, 0); PG8_LDB(B1, 0, 1); PG8_SCHED; PG8_LDA(At, 0, 0); PG8_STAGE(PG8_SA(1, 1), a1 + hstep, voffA);
            PG8_WAIT_V(8); PG8_WAIT_L(0); PG8_BAR; PG8_MMA(0, 0, At, B0); PG8_MMA(0, 1, At, B1); PG8_BAR; PG8_SCHED;
            PG8_LDA(At, 0, 1); PG8_STAGE(PG8_SB(0, 0), b2, voffB); PG8_STAGE(PG8_SB(0, 1), b2 + hstep, voffB); PG8_STAGE(PG8_SA(0, 0), a2, voffA);
            PG8_WAIT_V(8); PG8_WAIT_L(0); PG8_BAR; PG8_MMA(1, 0, At, B0); PG8_MMA(1, 1, At, B1); PG8_BAR; PG8_SCHED;
            PG8_LDB(B0, 1, 0); PG8_LDB(B1, 1, 1); PG8_SCHED; PG8_LDA(At, 1, 0); PG8_STAGE(PG8_SA(0, 1), a2 + hstep, voffA);
            PG8_WAIT_V(8); PG8_WAIT_L(0); PG8_BAR; PG8_MMA(0, 0, At, B0); PG8_MMA(0, 1, At, B1); PG8_BAR; PG8_SCHED;
            PG8_LDA(At, 1, 1); PG8_STAGE(PG8_SB(1, 0), b3, voffB); PG8_STAGE(PG8_SB(1, 1), b3 + hstep, voffB); PG8_STAGE(PG8_SA(1, 0), a3, voffA);
            PG8_WAIT_V(8); PG8_WAIT_L(0); PG8_BAR; PG8_MMA(1, 0, At, B0); PG8_MMA(1, 1, At, B1); PG8_BAR; PG8_SCHED;
            } else {
            PG8_LDB(B0, 0, 0); PG8_SCHED; PG8_LDA(At, 0, 0); PG8_STAGE(PG8_SA(1, 1), a1 + hstep, voffA);
            PG8_WAIT_L(8); PG8_BAR; PG8_WAIT_L(0); PG8_MMA(0, 0, At, B0); PG8_BAR; PG8_SCHED;
            PG8_LDB(B1, 0, 1); PG8_STAGE(PG8_SB(0, 0), b2, voffB);
            PG8_BAR; PG8_WAIT_L(0); PG8_MMA(0, 1, At, B1); PG8_BAR;
            PG8_LDA(At, 0, 1); PG8_STAGE(PG8_SA(0, 0), a2, voffA);
            PG8_BAR; PG8_WAIT_L(0); PG8_MMA(1, 0, At, B0); PG8_BAR; PG8_SCHED;
            PG8_STAGE(PG8_SB(0, 1), b2 + hstep, voffB);
            PG8_WAIT_V(6); PG8_BAR; PG8_MMA(1, 1, At, B1); PG8_BAR;
            PG8_LDB(B0, 1, 0); PG8_SCHED; PG8_LDA(At, 1, 0); PG8_STAGE(PG8_SA(0, 1), a2 + hstep, voffA);
            PG8_WAIT_L(8); PG8_BAR; PG8_WAIT_L(0); PG8_MMA(0, 0, At, B0); PG8_BAR; PG8_SCHED;
            PG8_LDB(B1, 1, 1); PG8_STAGE(PG8_SB(1, 0), b3, voffB);
            PG8_BAR; PG8_WAIT_L(0); PG8_MMA(0, 1, At, B1); PG8_BAR;
            PG8_LDA(At, 1, 1); PG8_STAGE(PG8_SA(1, 0), a3, voffA);
            PG8_BAR; PG8_WAIT_L(0); PG8_MMA(1, 0, At, B0); PG8_BAR; PG8_SCHED;
            PG8_STAGE(PG8_SB(1, 1), b3 + hstep, voffB);
            PG8_WAIT_V(6); PG8_BAR; PG8_MMA(1, 1, At, B1); PG8_BAR;
            }
        }
        if constexpr (ALIGN_EPI) { if (wr == 0) PG8_BAR; }
        if constexpr (!Epi::AFTER_DRAIN) { E(acc, cur, wr, wc, fr, fq); S.done(cur); }
        if (!has_next) break;
#pragma unroll
        for (int a = 0; a < 2; ++a)
#pragma unroll
            for (int b = 0; b < 2; ++b)
#pragma unroll
                for (int m = 0; m < 4; ++m)
#pragma unroll
                    for (int n = 0; n < 2; ++n) acc[a][b][m][n] = (f32x4){0.f, 0.f, 0.f, 0.f};
        cur = nxt; cA = nA; cB = nB; ++ui;
        if constexpr (ALIGN_EPI) { if (wr == 1) PG8_BAR; }
    }
    PG8_WAIT_V(0);
    if constexpr (!ALIGN_EPI) { if (wr == 0) PG8_BAR; }
    PG8_BAR;
    if constexpr (Epi::AFTER_DRAIN) { E.fused(acc, cur, wr, wc, fr, fq, lds, wid, lane); S.done(cur); }
#undef PG8_SA
#undef PG8_SB
#undef PG8_STAGE
#undef PG8_LDA
#undef PG8_LDB
#undef PG8_MMA
#undef PG8_WAIT_V
#undef PG8_WAIT_L
#undef PG8_BAR
#undef PG8_SCHED
}
}
#define LAS __attribute__((address_space(3)))
typedef unsigned short bf16;
typedef short bf16x8 __attribute__((ext_vector_type(8)));
typedef short s16x4 __attribute__((ext_vector_type(4)));
typedef float f32x4 __attribute__((ext_vector_type(4)));
typedef unsigned u32x4 __attribute__((ext_vector_type(4)));
typedef unsigned u32x2 __attribute__((ext_vector_type(2)));

constexpr int NB = 8, T = 4096, D = 1024, M = NB * T, DEPTH = 4;
constexpr int IN_COLS = 2852, DFF = 2816;
constexpr float EPS = 1e-6f;
constexpr float LOG2E = 1.4426950408889634f;
constexpr size_t MiB = 1u << 20;
constexpr size_t WS_X = 0, WS_XN = 128 * MiB, WS_ACONV = 192 * MiB, WS_Q = 224 * MiB, WS_KCR = 272 * MiB, WS_VCR = 288 * MiB, WS_KS = 304 * MiB, WS_KW = 320 * MiB,
                 WS_VST = 336 * MiB, WS_VWT = 352 * MiB, WS_HFF = 192 * MiB,
                 WS_WSET = 368 * MiB, WSET_BYTES = 27 * MiB,
                 OFF_WIN = 0, OFF_WOUT = 6 * MiB, OFF_WGU = 8 * MiB, OFF_WD = 19 * MiB, OFF_CMPW = 25 * MiB,
                 WS_XB = 422 * MiB, WS_LOHI = 0, WS_ASCR = 32 * MiB,
                 WS_G = 486 * MiB, WS_KC = 491 * MiB, WS_VCT = 492 * MiB, WS_PE = 493 * MiB, WS_RSQ = 494 * MiB, WS_CTL = 498 * MiB, WS_END = 499 * MiB;
constexpr int LDS_BYTES = 163840, MISC_OFF = 163840 - 512, CTL_ZERO_BYTES = 16384;
constexpr int NPH = 11, NPHASES = DEPTH * NPH + 1;

struct Args {
    const float* in[18]; float* out; unsigned char* ws; int ph_lo, ph_hi;
};
#ifndef USE_PT
#define USE_PT 0
#endif
struct PT {
    LAS const unsigned long long* t; unsigned char* ws; const Args* ap;
#if USE_PT
    __device__ __forceinline__ unsigned long long raw(int i) const { const unsigned long long v = t[i]; return (unsigned long long)__builtin_amdgcn_readfirstlane((unsigned)v) | ((unsigned long long)__builtin_amdgcn_readfirstlane((unsigned)(v >> 32)) << 32); }
#else
    __device__ __forceinline__ unsigned long long raw(int i) const { return i < 18 ? (unsigned long long)ap->in[i] : (i == 18 ? (unsigned long long)ap->out : (unsigned long long)ap->ws); }
#endif
    __device__ __forceinline__ const float* in(int i) const { return (const float*)raw(i); }
};

__device__ __forceinline__ unsigned f2bf(float f) { unsigned u = __builtin_bit_cast(unsigned, f); return (u + 0x7fffu + ((u >> 16) & 1u)) >> 16; }
typedef float f32x2_cv __attribute__((ext_vector_type(2))); typedef __bf16 bf16x2_cv __attribute__((ext_vector_type(2)));
__device__ __forceinline__ unsigned pk2(float lo, float hi) { const f32x2_cv v = {lo, hi}; const bf16x2_cv b = __builtin_convertvector(v, bf16x2_cv); return __builtin_bit_cast(unsigned, b); }
__device__ __forceinline__ float bf2f(unsigned short h) { return __builtin_bit_cast(float, (unsigned)h << 16); }
__device__ __forceinline__ float wave_sum(float v) {
#pragma unroll
    for (int o = 1; o < 64; o <<= 1) v += __shfl_xor(v, o);
    return v;
}
#define LDS_WAIT() asm volatile("s_waitcnt lgkmcnt(0)" ::: "memory")

__device__ __forceinline__ void transpose_item(const float* W, int ldw, int ncols, bf16* WTrow0, int ldt, LAS float* scr, int k0, int n0, int lane, const float* gain = nullptr) {
    const int cq = lane & 15, kr = lane >> 4;
#pragma unroll 8
    for (int i = 0; i < 16; ++i) {
        const int kk = 4 * i + kr, n = n0 + 4 * cq;
        f32x4 v = {0.f, 0.f, 0.f, 0.f};
        if (n < ncols) v = *(const f32x4*)(W + (size_t)(k0 + kk) * ldw + n);
        LAS float* d = scr + kk * 65 + 4 * cq;
        d[0] = v[0]; d[1] = v[1]; d[2] = v[2]; d[3] = v[3];
    }
    LDS_WAIT(); asm volatile("" ::: "memory");
    const int c = lane & 7;
    f32x4 ga = {1.f, 1.f, 1.f, 1.f}, gb = ga;
    if (gain) { ga = *(const f32x4*)(gain + k0 + 8 * c); gb = *(const f32x4*)(gain + k0 + 8 * c + 4); }
#pragma unroll
    for (int j = 0; j < 8; ++j) { const int n = (lane >> 3) + 8 * j; const LAS float* s = scr + (8 * c) * 65 + n;
        u32x4 o; o.x = pk2(s[0 * 65] * ga[0], s[1 * 65] * ga[1]); o.y = pk2(s[2 * 65] * ga[2], s[3 * 65] * ga[3]); o.z = pk2(s[4 * 65] * gb[0], s[5 * 65] * gb[1]); o.w = pk2(s[6 * 65] * gb[2], s[7 * 65] * gb[3]);
        *(u32x4*)(WTrow0 + (size_t)n * ldt + k0 + 8 * c) = o; }
    LDS_WAIT(); asm volatile("" ::: "memory");
}
__device__ __forceinline__ int win_row(int n0) {
    if (n0 < 2048) return n0;
    if (n0 < 2304) return 2560 + (n0 - 2048);
    if (n0 < 2560) return 2048 + (n0 - 2304);
    if (n0 < 2816) return 2816 + (n0 - 2560);
    return 2304 + (n0 - 2816);
}
__device__ __forceinline__ int wgu_row(int n0) { const int h = n0 < DFF ? n0 : n0 - DFF; return 256 * (h >> 7) + (h & 127) + (n0 < DFF ? 0 : 128); }

__device__ __forceinline__ void prologue_layer(const PT& a, int layer, LAS unsigned char* lds, int blk, int G) {
    const int tid = my_tid(), lane = tid & 63, wave = tid >> 6;
    LAS float* scr = (LAS float*)(lds + wave * 17408);
    const int gw = blk * 8 + wave, NGW = G * 8;
    unsigned char* ws = a.ws; unsigned char* wset = ws + WS_WSET + (size_t)(layer & 1) * WSET_BYTES;
    bf16* WIN = (bf16*)(wset + OFF_WIN); bf16* WOUT = (bf16*)(wset + OFF_WOUT); bf16* WGU = (bf16*)(wset + OFF_WGU); bf16* WD = (bf16*)(wset + OFF_WD); bf16* CMPW = (bf16*)(wset + OFF_CMPW);
    const float* g1 = a.in(1) + (size_t)layer * D; const float* g2 = a.in(14) + (size_t)layer * D;
    const float* w_in = a.in(2) + (size_t)layer * D * IN_COLS;
    const float* w_out = a.in(13) + (size_t)layer * D * D;
    const float* w_gu = a.in(15) + (size_t)layer * D * 2 * DFF;
    const float* w_dn = a.in(16) + (size_t)layer * DFF * D;
    const float* kw1 = a.in(8) + (size_t)layer * 32 * 64 * 256;
    const float* vw1 = a.in(11) + (size_t)layer * 32 * 64 * 256;
    constexpr int I_IN = 16 * 45, I_OUT = 16 * 16, I_GU = 16 * 88, I_DN = 44 * 16, I_C = 16 * 4;
    constexpr int NIT = I_IN + I_OUT + I_GU + I_DN + 4 * I_C;
    for (int it = gw; it < NIT; it += NGW) {
        int r = it;
        if (r < I_IN) { const int kb = r / 45, nb = r % 45; transpose_item(w_in, IN_COLS, IN_COLS, WIN + (size_t)win_row(64 * nb) * D, D, scr, 64 * kb, 64 * nb, lane, g1); continue; } r -= I_IN;
        if (r < I_OUT) { const int kb = r / 16, nb = r % 16; transpose_item(w_out, D, D, WOUT + (size_t)(64 * nb) * D, D, scr, 64 * kb, 64 * nb, lane); continue; } r -= I_OUT;
        if (r < I_GU) { const int kb = r / 88, nb = r % 88; transpose_item(w_gu, 2 * DFF, 2 * DFF, WGU + (size_t)wgu_row(64 * nb) * D, D, scr, 64 * kb, 64 * nb, lane, g2); continue; } r -= I_GU;
        if (r < I_DN) { const int kb = r / 16, nb = r % 16; transpose_item(w_dn, D, D, WD + (size_t)(64 * nb) * DFF, DFF, scr, 64 * kb, 64 * nb, lane); continue; } r -= I_DN;
        { const int q = r / I_C, rr = r % I_C, kb = rr / 4, nb = rr % 4;
          const float* src = ((q < 2) ? kw1 : vw1) + (size_t)(q & 1) * 1024 * 256;
          transpose_item(src, 256, 256, CMPW + (size_t)(q * 256 + 64 * nb) * D, D, scr, 64 * kb, 64 * nb, lane); }
    }
    { u32x4 z = {0u, 0u, 0u, 0u}; u32x4* p = (u32x4*)(WIN + (size_t)(2304 + 64) * D);
      for (int i = blk * 512 + tid; i < 192 * D / 8; i += G * 512) p[i] = z; }
    if (blk < 16) {
        __syncthreads();
        const int kvb = blk >> 3, cg = blk & 7;
        const float* pe = (kvb == 0 ? a.in(7) : a.in(10)) + (size_t)layer * 2048;
        const float* w1 = kvb == 0 ? kw1 : vw1;
        LAS float* red = (LAS float*)lds;
        const int c = tid & 31, lg = tid >> 5;
        float s = 0.f;
#pragma unroll 16
        for (int i = 0; i < 128; ++i) { const int ld = lg * 128 + i; s += pe[ld] * w1[(size_t)ld * 256 + cg * 32 + c]; }
        red[lg * 32 + c] = s;
        __syncthreads();
        if (tid < 32) { float t = 0.f;
#pragma unroll
            for (int j = 0; j < 16; ++j) t += red[j * 32 + tid];
            ((float*)(ws + WS_PE))[(layer & 1) * 512 + kvb * 256 + cg * 32 + tid] = t; }
        __syncthreads();
    }
}

__device__ __forceinline__ void first_rows(const float* x, bf16* XB, float* RSQ, int blk, int G) {
    const int tid = my_tid(), lane = tid & 63, wave = tid >> 6;
    const int gw = blk * 8 + wave, NGW = G * 8;
    for (int m = gw; m < M; m += NGW) {
        const f32x4* xr = (const f32x4*)(x + (size_t)m * D) + lane;
        unsigned long long* o8 = (unsigned long long*)(XB + (size_t)m * D) + lane;
        float s = 0.f;
#pragma unroll
        for (int j = 0; j < 4; ++j) { const f32x4 v = xr[64 * j]; s += (v.x * v.x + v.y * v.y) + (v.z * v.z + v.w * v.w); o8[64 * j] = (unsigned long long)pk2(v.x, v.y) | ((unsigned long long)pk2(v.z, v.w) << 32); }
        s = wave_sum(s);
        if (lane < 16) RSQ[(size_t)m * 16 + lane] = lane == 0 ? s : 0.f;
    }
}
__device__ __forceinline__ void final_rows(const bf16* xb, const float* RSQ, const float* gain, float* out, int blk, int G) {
    const int tid = my_tid(), lane = tid & 63, wave = tid >> 6;
    const int gw = blk * 8 + wave, NGW = G * 8;
    f32x4 gv[4];
#pragma unroll
    for (int j = 0; j < 4; ++j) gv[j] = *((const f32x4*)gain + lane + 64 * j);
    for (int m = gw; m < M; m += NGW) {
        const float rstd = 1.0f / sqrtf(pg8::row_sumsq(RSQ, m) * (1.f / D) + EPS);
        const unsigned long long* xr = (const unsigned long long*)(xb + (size_t)m * D) + lane;
        f32x4* o = (f32x4*)(out + (size_t)m * D) + lane;
#pragma unroll
        for (int j = 0; j < 4; ++j) {
            const unsigned long long w = xr[64 * j]; const unsigned lo = (unsigned)w, hi = (unsigned)(w >> 32);
            const f32x4 v = {__builtin_bit_cast(float, lo << 16), __builtin_bit_cast(float, lo & 0xffff0000u), __builtin_bit_cast(float, hi << 16), __builtin_bit_cast(float, hi & 0xffff0000u)};
            o[64 * j] = v * rstd * gv[j];
        }
    }
}

__device__ __forceinline__ void conv_phase(const PT& a, int layer, LAS unsigned char* lds, int blk, int G) {
    const int tid = my_tid(), lane = tid & 63, wave = tid >> 6;
    LAS float* Y = (LAS float*)lds;
    LAS float* C = Y + 62 * 256;
    const bf16* ACONV = (const bf16*)(a.ws + WS_ACONV);
    bf16* MIX = (bf16*)(a.ws + WS_XN);
    const float* cw = a.in(3) + (size_t)layer * 31 * 256;
    const float* cb = a.in(4) + (size_t)layer * 256;
    const float* lg = a.in(5) + (size_t)layer * 256;
    const float* lb = a.in(6) + (size_t)layer * 256;
    const int c = tid & 255, half = tid >> 8;
    float w[31];
#pragma unroll
    for (int k = 0; k < 31; ++k) w[k] = cw[k * 256 + c];
    const float bias = cb[c];
    const f32x4 g4 = *((const f32x4*)lg + lane), b4 = *((const f32x4*)lb + lane);
    const int cq = blk >> 3, cnt = (G == 256) ? (cq < 16 ? 2 : 6) : 0, tbase = (blk & 7) * 128 + (cq < 16 ? 2 * cq : 32 + 6 * (cq - 16));
    u32x4 ru[4], rv[4];
#define CONV_FETCH(tile_) do { const int b_ = (tile_) >> 7, t0_ = ((tile_) & 127) * 32; \
        _Pragma("unroll") for (int k_ = 0; k_ < 4; ++k_) { const int idx_ = tid + 512 * k_; const int t_ = t0_ - 30 + (idx_ >> 5); \
            ru[k_] = (u32x4){0u, 0u, 0u, 0u}; rv[k_] = ru[k_]; \
            if (idx_ < 62 * 32 && t_ >= 0) { const bf16* p_ = ACONV + ((size_t)b_ * T + t_) * 512 + (idx_ & 31) * 8; ru[k_] = *(const u32x4*)p_; rv[k_] = *(const u32x4*)(p_ + 256); } } } while (0)
    const int tl0 = (G == 256) ? 0 : blk, tlim = (G == 256) ? cnt : 1024, tstep = (G == 256) ? 1 : G;
    if (tl0 < tlim) CONV_FETCH((G == 256) ? tbase + tl0 : tl0);
    for (int tl = tl0; tl < tlim; tl += tstep) {
        const int tile = (G == 256) ? tbase + tl : tl;
        const int b = tile >> 7, t0 = (tile & 127) * 32;
#pragma unroll
        for (int k = 0; k < 4; ++k) {
            const int idx = tid + 512 * k;
            if (idx < 62 * 32) {
                const int rr = idx >> 5, ch = idx & 31;
                f32x4 y0, y1;
                const u32x4 u = ru[k], v = rv[k];
#pragma unroll
                for (int e = 0; e < 4; ++e) {
                    const float ulo = __builtin_bit_cast(float, u[e] << 16), uhi = __builtin_bit_cast(float, u[e] & 0xffff0000u);
                    const float vlo = __builtin_bit_cast(float, v[e] << 16), vhi = __builtin_bit_cast(float, v[e] & 0xffff0000u);
                    const float r0 = ulo * pg8::fast_sigmoid(vlo), r1 = uhi * pg8::fast_sigmoid(vhi);
                    if (e < 2) { y0[2 * e] = r0; y0[2 * e + 1] = r1; } else { y1[2 * (e - 2)] = r0; y1[2 * (e - 2) + 1] = r1; }
                }
                *(LAS f32x4*)(Y + rr * 256 + ch * 8) = y0; *(LAS f32x4*)(Y + rr * 256 + ch * 8 + 4) = y1;
            }
        }
        __syncthreads();
        if (tl + tstep < tlim) CONV_FETCH((G == 256) ? tbase + tl + tstep : tl + tstep);
        {
            float acc[16];
#pragma unroll
            for (int tt = 0; tt < 16; ++tt) acc[tt] = bias;
#pragma unroll
            for (int r2 = 0; r2 < 46; ++r2) {
                const float yv = Y[(half * 16 + r2) * 256 + c];
#pragma unroll
                for (int tt = 0; tt < 16; ++tt) { const int k = r2 - tt; if (k >= 0 && k <= 30) acc[tt] += w[k] * yv; }
            }
#pragma unroll
            for (int tt = 0; tt < 16; ++tt) C[(half * 16 + tt) * 256 + c] = acc[tt];
        }
        __syncthreads();
#pragma unroll
        for (int i = 0; i < 4; ++i) {
            const int tok = wave * 4 + i;
            const f32x4 v = *(const LAS f32x4*)(C + tok * 256 + lane * 4);
            const float mu = wave_sum((v.x + v.y) + (v.z + v.w)) * (1.f / 256.f);
            const f32x4 dv = v - mu;
            const float var = wave_sum((dv.x * dv.x + dv.y * dv.y) + (dv.z * dv.z + dv.w * dv.w)) * (1.f / 256.f);
            const float rstd = 1.0f / sqrtf(var + EPS);
            f32x4 y = dv * rstd * g4 + b4;
            y.x = pg8::fast_silu(y.x); y.y = pg8::fast_silu(y.y); y.z = pg8::fast_silu(y.z); y.w = pg8::fast_silu(y.w);
            *(unsigned long long*)(MIX + ((size_t)b * T + t0 + tok) * D + lane * 4) = (unsigned long long)pk2(y.x, y.y) | ((unsigned long long)pk2(y.z, y.w) << 32);
        }
    }
    __syncthreads();
}

__device__ __forceinline__ void cmp2_phase(const PT& a, int layer, LAS unsigned char* lds, int blk, int G) {
    const int tid = my_tid(), lane = tid & 63, wave = tid >> 6;
    LAS float* hL = (LAS float*)(lds + wave * 4096);
    LAS float* W2L = (LAS float*)(lds + 32768);
    const float* LOHI = (const float*)(a.ws + WS_LOHI);
    const float* PE = (const float*)(a.ws + WS_PE) + (layer & 1) * 512;
    bf16* KC = (bf16*)(a.ws + WS_KC); bf16* VCT = (bf16*)(a.ws + WS_VCT);
    const int gw = blk * 8 + wave, NGW = G * 8;
    const int nround = (G == 256) ? 2 : (2 * NB * 255 + NGW - 1) / NGW;
    for (int rd = 0; rd < nround; ++rd) {
        int kv, b, n; bool act;
        if (G == 256) {
            const int lw = (blk >> 3) * 8 + wave; kv = rd; b = blk & 7; n = lw; act = lw < 255;
            const float* w2g = (kv == 0 ? a.in(9) : a.in(12)) + (size_t)layer * 256 * 64;
            __syncthreads();
#pragma unroll
            for (int i = 0; i < 8; ++i) *(LAS f32x4*)(W2L + (tid + 512 * i) * 4) = *((const f32x4*)w2g + tid + 512 * i);
            __syncthreads();
        } else { const int gi = gw + rd * NGW; act = gi < 2 * NB * 255; kv = act ? gi / (NB * 255) : 0; const int rem = act ? gi % (NB * 255) : 0; b = rem / 255; n = rem % 255; }
        if (!act) continue;
        const float* w2 = (kv == 0 ? a.in(9) : a.in(12)) + (size_t)layer * 256 * 64;
        const f32x4 pe4 = *((const f32x4*)(PE + kv * 256) + lane);
#pragma unroll
        for (int g = 0; g < 4; ++g) {
            const size_t R0 = (size_t)kv * 8192 + ((size_t)b * 256 + n) * 4 + g, R1 = R0 + 4;
            const f32x4 lo = *((const f32x4*)(LOHI + R0 * 512) + lane), hi = *((const f32x4*)(LOHI + R1 * 512 + 256) + lane);
            f32x4 h = lo + hi + pe4;
            h.x = pg8::fast_silu(h.x); h.y = pg8::fast_silu(h.y); h.z = pg8::fast_silu(h.z); h.w = pg8::fast_silu(h.w);
            *(LAS f32x4*)(hL + g * 256 + lane * 4) = h;
        }
        LDS_WAIT(); asm volatile("" ::: "memory");
        float acc[4] = {0.f, 0.f, 0.f, 0.f};
#pragma unroll 4
        for (int j4 = 0; j4 < 64; ++j4) {
            float wv[4];
#pragma unroll
            for (int e = 0; e < 4; ++e) wv[e] = (G == 256) ? W2L[(4 * j4 + e) * 64 + lane] : w2[(4 * j4 + e) * 64 + lane];
#pragma unroll
            for (int g = 0; g < 4; ++g) { const f32x4 hv = *(const LAS f32x4*)(hL + g * 256 + 4 * j4); acc[g] += hv.x * wv[0] + hv.y * wv[1] + hv.z * wv[2] + hv.w * wv[3]; }
        }
        LDS_WAIT(); asm volatile("" ::: "memory");
#pragma unroll
        for (int g = 0; g < 4; ++g) {
            const unsigned short o = (unsigned short)f2bf(acc[g]);
            if (kv == 0) { KC[((size_t)(b * 4 + g) * 256 + n) * 64 + lane] = o; if (n == 254) KC[((size_t)(b * 4 + g) * 256 + 255) * 64 + lane] = 0; }
            else { VCT[((size_t)(b * 4 + g) * 64 + lane) * 256 + n] = o; if (n == 254) VCT[((size_t)(b * 4 + g) * 64 + lane) * 256 + 255] = 0; }
        }
    }
    __syncthreads();
}
namespace att {
constexpr int KSTR = 128, TILE_B = 64 * KSTR;
constexpr int NBUF = 4, OFF_K = 0, OFF_V = NBUF * TILE_B, OFF_IMP = 2 * NBUF * TILE_B, OFF_SELM = OFF_IMP + 128 * 65 * 4, OFF_BUN = OFF_SELM + 1024, OFF_Q = OFF_BUN + 64;
constexpr float NEG = -1.0e30f, M0REF = -40.0f;
struct P { unsigned char* ws; f32x4* scr; };

#define MFMA16(a, b, c) __builtin_amdgcn_mfma_f32_16x16x32_bf16((a), (b), (c), 0, 0, 0)

__device__ __forceinline__ void qk_tile3(f32x4 (&st)[3][4], const LAS unsigned char* Kl, const LAS unsigned char* QL, int fr, int fq) {
    bf16x8 kf[4][2];
#pragma unroll
    for (int kt = 0; kt < 4; ++kt)
#pragma unroll
        for (int ks = 0; ks < 2; ++ks) kf[kt][ks] = *(const LAS bf16x8*)(Kl + (16 * kt + fr) * KSTR + (((4 * ks + fq) ^ (fr & 7)) << 4));
#pragma unroll
    for (int r = 0; r < 3; ++r)
#pragma unroll
        for (int kt = 0; kt < 4; ++kt) {
            f32x4 acc = {0.f, 0.f, 0.f, 0.f};
#pragma unroll
            for (int ks = 0; ks < 2; ++ks) acc = MFMA16(kf[kt][ks], *(const LAS bf16x8*)(QL + (r * 2 + ks) * 1024), acc);
            st[r][kt] = acc;
        }
}
__device__ __forceinline__ void qk_tile3_aug(f32x4 (&st)[3][4], const LAS unsigned char* Kl, const LAS unsigned char* QL, const unsigned (&qaw)[3], const unsigned (&kaw)[4], int fr, int fq) {
#pragma unroll
    for (int kt = 0; kt < 4; ++kt) {
        const LAS unsigned char* krow = Kl + (16 * kt + fr) * KSTR;
        const bf16x8 kf0 = *(const LAS bf16x8*)(krow + ((fq ^ (fr & 7)) << 4));
        const bf16x8 kf1 = *(const LAS bf16x8*)(krow + (((4 + fq) ^ (fr & 7)) << 4));
        const u32x4 ka = {kaw[kt], 0u, 0u, 0u};
#pragma unroll
        for (int r = 0; r < 3; ++r) {
            const u32x4 qa = {qaw[r], 0u, 0u, 0u};
            f32x4 acc = MFMA16(__builtin_bit_cast(bf16x8, ka), __builtin_bit_cast(bf16x8, qa), ((f32x4){0.f, 0.f, 0.f, 0.f}));
            acc = MFMA16(kf0, *(const LAS bf16x8*)(QL + (r * 2) * 1024), acc);
            st[r][kt] = MFMA16(kf1, *(const LAS bf16x8*)(QL + (r * 2 + 1) * 1024), acc);
        }
    }
}
__device__ __forceinline__ void pv_tile3(f32x4 (&o)[3][4], const LAS unsigned char* Vl, const f32x4 (&p)[3][4], int fr, int fq) {
    bf16x8 pb[3][2];
#pragma unroll
    for (int r = 0; r < 3; ++r)
#pragma unroll
        for (int kk = 0; kk < 2; ++kk) {
            u32x4 w; w.x = pk2(p[r][2 * kk][0], p[r][2 * kk][1]); w.y = pk2(p[r][2 * kk][2], p[r][2 * kk][3]); w.z = pk2(p[r][2 * kk + 1][0], p[r][2 * kk + 1][1]); w.w = pk2(p[r][2 * kk + 1][2], p[r][2 * kk + 1][3]);
            pb[r][kk] = __builtin_bit_cast(bf16x8, w);
        }
#pragma unroll
    for (int dt = 0; dt < 4; ++dt)
#pragma unroll
        for (int kk = 0; kk < 2; ++kk) {
            const LAS unsigned char* vrow = Vl + (16 * dt + fr) * KSTR + 8 * (fq & 1);
            const u32x2 v0 = *(const LAS u32x2*)(vrow + (((4 * kk + (fq >> 1)) ^ (fr & 7)) << 4)), v1 = *(const LAS u32x2*)(vrow + (((4 * kk + 2 + (fq >> 1)) ^ (fr & 7)) << 4));
            u32x4 w; w.x = v0.x; w.y = v0.y; w.z = v1.x; w.w = v1.y;
            const bf16x8 vf = __builtin_bit_cast(bf16x8, w);
#pragma unroll
            for (int r = 0; r < 3; ++r) o[r][dt] = MFMA16(vf, pb[r][kk], o[r][dt]);
        }
}
__device__ __forceinline__ float ex2(float x) { return __builtin_amdgcn_exp2f(x); }
__device__ __forceinline__ float rmax4(float a) {
    unsigned x = __builtin_bit_cast(unsigned, a);
    auto r1 = __builtin_amdgcn_permlane16_swap(x, x, false, false);
    unsigned u0 = r1[0], u1 = r1[1];
    asm volatile("" : "+v"(u0), "+v"(u1));
    a = fmaxf(__builtin_bit_cast(float, u0), __builtin_bit_cast(float, u1));
    x = __builtin_bit_cast(unsigned, a);
    auto r2 = __builtin_amdgcn_permlane32_swap(x, x, false, false);
    u0 = r2[0]; u1 = r2[1];
    asm volatile("" : "+v"(u0), "+v"(u1));
    return fmaxf(__builtin_bit_cast(float, u0), __builtin_bit_cast(float, u1));
}
__device__ __forceinline__ float max16(const f32x4 (&v)[4]) {
    float a = fmaxf(fmaxf(v[0][0], v[0][1]), fmaxf(v[0][2], v[0][3]));
#pragma unroll
    for (int kt = 1; kt < 4; ++kt) a = fmaxf(a, fmaxf(fmaxf(v[kt][0], v[kt][1]), fmaxf(v[kt][2], v[kt][3])));
    return rmax4(a);
}

__device__ __forceinline__ void qk_half(f32x4 (&st)[3][2], const LAS unsigned char* Kl, const LAS unsigned char* QL, const unsigned (&qaw)[3], const unsigned (&kaw)[4], int hf, const float (&cinit)[3], int fr, int fq) {
    const int sw = fr & 7;
#pragma unroll
    for (int k2 = 0; k2 < 2; ++k2) {
        const LAS unsigned char* krow = Kl + (32 * hf + 16 * k2 + fr) * KSTR;
        const bf16x8 kf0 = *(const LAS bf16x8*)(krow + ((fq ^ sw) << 4));
        const bf16x8 kf1 = *(const LAS bf16x8*)(krow + (((4 + fq) ^ sw) << 4));
        const u32x4 ka = {hf ? kaw[2 + k2] : kaw[k2], 0u, 0u, 0u};
#pragma unroll
        for (int r = 0; r < 3; ++r) {
            const u32x4 qa = {qaw[r], 0u, 0u, 0u};
            f32x4 acc = MFMA16(__builtin_bit_cast(bf16x8, ka), __builtin_bit_cast(bf16x8, qa), ((f32x4){cinit[r], cinit[r], cinit[r], cinit[r]}));
            acc = MFMA16(kf0, *(const LAS bf16x8*)(QL + (r * 2) * 1024), acc);
            st[r][k2] = MFMA16(kf1, *(const LAS bf16x8*)(QL + (r * 2 + 1) * 1024), acc);
        }
    }
}
__device__ __forceinline__ float max8(const f32x4 (&v)[2]) { return fmaxf(fmaxf(fmaxf(v[0][0], v[0][1]), fmaxf(v[0][2], v[0][3])), fmaxf(fmaxf(v[1][0], v[1][1]), fmaxf(v[1][2], v[1][3]))); }
template <int MODE>
__device__ __forceinline__ void flash_step(const LAS unsigned char* Kl, const LAS unsigned char* Vl, const LAS unsigned char* QL, const unsigned (&qaw)[3], const unsigned (&kaw)[4], const float (&sl2)[3],
                                           int rel, int dj, bool sel, bool need_mask, float (&m)[3], f32x4 (&O)[3][5], int fr, int fq) {
    constexpr float THR = 6.0f;
    const float djf = (float)dj;
    const int sw = fr & 7;
    float cmo[3];
#pragma unroll
    for (int r = 0; r < 3; ++r) cmo[r] = sl2[r] * djf - m[r];
#pragma unroll 1
    for (int hf = 0; hf < 2; ++hf) {
        f32x4 st[3][2];
        bf16x8 kfa[2], kfb[2];
#pragma unroll
        for (int k2 = 0; k2 < 2; ++k2) {
            const LAS unsigned char* krow = Kl + (32 * hf + 16 * k2 + fr) * KSTR;
            kfa[k2] = *(const LAS bf16x8*)(krow + ((fq ^ sw) << 4));
            kfb[k2] = *(const LAS bf16x8*)(krow + (((4 + fq) ^ sw) << 4));
        }
        __builtin_amdgcn_s_setprio(1);
#pragma unroll
        for (int r = 0; r < 3; ++r) {
            const u32x4 qa = {qaw[r], 0u, 0u, 0u};
#pragma unroll
            for (int k2 = 0; k2 < 2; ++k2) {
                const u32x4 ka = {hf ? kaw[2 + k2] : kaw[k2], 0u, 0u, 0u};
                f32x4 acc = MFMA16(__builtin_bit_cast(bf16x8, ka), __builtin_bit_cast(bf16x8, qa), ((f32x4){cmo[r], cmo[r], cmo[r], cmo[r]}));
                acc = MFMA16(kfa[k2], *(const LAS bf16x8*)(QL + (r * 2) * 1024), acc);
                st[r][k2] = MFMA16(kfb[k2], *(const LAS bf16x8*)(QL + (r * 2 + 1) * 1024), acc);
            }
        }
        __builtin_amdgcn_s_setprio(0);
        if (need_mask) {
#pragma unroll
            for (int k2 = 0; k2 < 2; ++k2)
#pragma unroll
                for (int e = 0; e < 4; ++e) {
                    const int pr = rel + 32 * hf + 16 * k2 + e;
                    bool ok = pr <= 0;
                    if (MODE == 0) ok = ok && sel; else ok = ok && (pr > -512);
#pragma unroll
                    for (int r = 0; r < 3; ++r) st[r][k2][e] = ok ? st[r][k2][e] : NEG;
                }
        }
        float a[3];
#pragma unroll
        for (int r = 0; r < 3; ++r) a[r] = fmaxf(fmaxf(fmaxf(st[r][0][0], st[r][0][1]), fmaxf(st[r][0][2], st[r][0][3])), fmaxf(fmaxf(st[r][1][0], st[r][1][1]), fmaxf(st[r][1][2], st[r][1][3])));
        if (__any(fmaxf(fmaxf(a[0], a[1]), a[2]) > THR)) {
#pragma unroll
            for (int r = 0; r < 3; ++r) {
                const float mx = rmax4(a[r]);
                const float delta = mx > THR ? mx : 0.f;
                m[r] += delta; cmo[r] -= delta;
                const float alpha = ex2(-delta);
#pragma unroll
                for (int dt = 0; dt < 5; ++dt) O[r][dt] = O[r][dt] * alpha;
#pragma unroll
                for (int k2 = 0; k2 < 2; ++k2) st[r][k2] = st[r][k2] - delta;
            }
        }
        bf16x8 vf[4];
#pragma unroll
        for (int dt = 0; dt < 4; ++dt) {
            const LAS unsigned char* vrow = Vl + (16 * dt + fr) * KSTR + 8 * (fq & 1);
            const u32x2 v0 = *(const LAS u32x2*)(vrow + (((4 * hf + (fq >> 1)) ^ sw) << 4)), v1 = *(const LAS u32x2*)(vrow + (((4 * hf + 2 + (fq >> 1)) ^ sw) << 4));
            u32x4 w; w.x = v0.x; w.y = v0.y; w.z = v1.x; w.w = v1.y;
            vf[dt] = __builtin_bit_cast(bf16x8, w);
        }
        const unsigned one2 = (fr == 0) ? 0x3f803f80u : 0u;
        const u32x4 w1 = {one2, one2, one2, one2};
        const bf16x8 vone = __builtin_bit_cast(bf16x8, w1);
#pragma unroll
        for (int r = 0; r < 3; ++r) {
#pragma unroll
            for (int k2 = 0; k2 < 2; ++k2)
#pragma unroll
                for (int e = 0; e < 4; ++e) st[r][k2][e] = ex2(st[r][k2][e]);
            u32x4 w; w.x = pk2(st[r][0][0], st[r][0][1]); w.y = pk2(st[r][0][2], st[r][0][3]); w.z = pk2(st[r][1][0], st[r][1][1]); w.w = pk2(st[r][1][2], st[r][1][3]);
            const bf16x8 pb = __builtin_bit_cast(bf16x8, w);
#pragma unroll
            for (int dt = 0; dt < 4; ++dt) O[r][dt] = MFMA16(vf[dt], pb, O[r][dt]);
            O[r][4] = MFMA16(vone, pb, O[r][4]);
        }
    }
}

#define ATT_DMA(buf, kp, vp, vstride) do { \
    __builtin_amdgcn_global_load_lds((const unsigned*)((kp) + lrow * 64 + lchs * 8), (LAS unsigned*)(lds + OFF_K + (buf) * TILE_B + w * 1024), 16, 0, 0); \
    __builtin_amdgcn_global_load_lds((const unsigned*)((vp) + (size_t)lrow * (vstride) + lchs * 8), (LAS unsigned*)(lds + OFF_V + (buf) * TILE_B + w * 1024), 16, 0, 0); } while (0)
#define ATT_WAIT_SYNC() do { asm volatile("s_waitcnt vmcnt(0) lgkmcnt(0)\n\ts_barrier" ::: "memory"); } while (0)
#define ATT_WAIT_SYNC2(more) do { if (more) asm volatile("s_waitcnt vmcnt(2) lgkmcnt(0)\n\ts_barrier" ::: "memory"); else asm volatile("s_waitcnt vmcnt(0) lgkmcnt(0)\n\ts_barrier" ::: "memory"); } while (0)
#define ATT_POP(rem_, j_) do { j_ = 63 - __builtin_clzll(rem_); rem_ &= ~(1ull << j_); } while (0)

#define ATT_QDMA(bb, gg, II) do { const bf16* q_ = (const bf16*)(p.ws + WS_Q) + ((size_t)(bb) * T + 128 * (II) + 16 * w + fr) * 768 + 3 * (gg) * 64 + 8 * fq; \
    _Pragma("unroll") for (int r_ = 0; r_ < 3; ++r_) _Pragma("unroll") for (int ks_ = 0; ks_ < 2; ++ks_) \
        __builtin_amdgcn_global_load_lds((const unsigned*)(q_ + r_ * 64 + 32 * ks_), (LAS unsigned*)(lds + OFF_Q + w * 6144 + (r_ * 2 + ks_) * 1024), 16, 0, 0); } while (0)
__device__ __forceinline__ void attn_item(LAS unsigned char* lds, const P& p, int b, int g, int I, bool first, int nbg, int nI) {
    const int tid = my_tid(), lane = tid & 63, w = __builtin_amdgcn_readfirstlane(tid >> 6), fr = lane & 15, fq = lane >> 4;
    const int tq = 128 * I + 16 * w + fr;
    const int iq = 2 * I + (w >> 2);
    const size_t row = (size_t)b * T + tq;
    const int bg = b * 4 + g;
    const int lrow = tid >> 3, lchs = (tid & 7) ^ (lrow & 7);
    LAS float* IMP = (LAS float*)(lds + OFF_IMP);
    LAS unsigned* SELM = (LAS unsigned*)(lds + OFF_SELM);
    LAS unsigned* BUN = (LAS unsigned*)(lds + OFF_BUN);
    for (int i = tid; i < 128 * 65; i += 512) IMP[i] = 0.f;
    if (tid < 2) BUN[tid] = 0u;
    LAS unsigned char* QL = lds + OFF_Q + w * 6144 + lane * 16;
    if (first) ATT_QDMA(b, g, I);
    float sl2[3];
#pragma unroll
    for (int r = 0; r < 3; ++r) {
        const int h = 3 * g + r;
        sl2[r] = (h < 8 ? exp2f(-(float)(h + 1)) : exp2f(-(0.5f + (float)(h - 8)))) * LOG2E;
    }
    LAS float* gp = (LAS float*)(lds + OFF_Q + 49152) + (16 * w + fr) * 12;
    if (fq < 3) { const float* gsrc = (const float*)(p.ws + WS_G) + row * 36 + 9 * g + 3 * fq; const float g0 = gsrc[0], g1 = gsrc[1], g2 = gsrc[2]; gp[3 * fq] = g0; gp[3 * fq + 1] = g1; gp[3 * fq + 2] = g2; }
    unsigned qaw[3], kaw[4];
#pragma unroll
    for (int r = 0; r < 3; ++r) { const unsigned hi = f2bf(sl2[r]); const unsigned lo = f2bf(sl2[r] - __builtin_bit_cast(float, hi << 16)); qaw[r] = (fq == 0) ? (hi | (lo << 16)) : 0u; }
#pragma unroll
    for (int kt = 0; kt < 4; ++kt) { const unsigned c = f2bf((float)(16 * kt + fr)); kaw[kt] = (fq == 0) ? (c | (c << 16)) : 0u; }
    unsigned qaw16[3];
#pragma unroll
    for (int r = 0; r < 3; ++r) { const float x = 16.0f * sl2[r]; const unsigned hi = f2bf(x); const unsigned lo = f2bf(x - __builtin_bit_cast(float, hi << 16)); qaw16[r] = (fq == 0) ? (hi | (lo << 16)) : 0u; }
    const int tqmin = 128 * I + 16 * w;
    const bf16* KCp = (const bf16*)(p.ws + WS_KC) + (size_t)bg * 256 * 64; const bf16* VCp = (const bf16*)(p.ws + WS_VCT) + (size_t)bg * 64 * 256;
    const int nT = (8 * I + 7 + 63) >> 6;
    const int tqmax = 128 * I + 16 * w + 15;
    float m[3], l[3];
#pragma unroll
    for (int r = 0; r < 3; ++r) { m[r] = M0REF; l[r] = 0.f; }
    for (int t = 0; t < nT; ++t) ATT_DMA(t, KCp + t * 64 * 64, VCp + t * 64, 256);
    ATT_WAIT_SYNC();
    for (int Tt = 0; Tt < nT; ++Tt) {
        if (1024 * Tt + 31 <= tqmax) {
            const LAS unsigned char* Kl = lds + OFF_K + Tt * TILE_B;
            const int crel = 16 * (64 * Tt + 4 * fq) - tq;
            const bool full = 16 * (64 * Tt + 63) + 31 <= tqmin;
            const float cb = (float)(1024 * Tt - tq) + 15.5f;
            float cmo[3];
#pragma unroll
            for (int r = 0; r < 3; ++r) cmo[r] = sl2[r] * cb - m[r];
#pragma unroll 1
            for (int hf = 0; hf < 2; ++hf) {
                f32x4 st[3][2]; qk_half(st, Kl, QL, qaw16, kaw, hf, cmo, fr, fq);
                if (!full) {
#pragma unroll
                    for (int k2 = 0; k2 < 2; ++k2)
#pragma unroll
                        for (int e = 0; e < 4; ++e) { const bool ok = crel + 512 * hf + 256 * k2 + 16 * e + 31 <= 0;
#pragma unroll
                            for (int r = 0; r < 3; ++r) st[r][k2][e] = ok ? st[r][k2][e] : NEG; }
                }
                float a[3];
#pragma unroll
                for (int r = 0; r < 3; ++r) a[r] = max8(st[r]);
                if (__any(fmaxf(fmaxf(a[0], a[1]), a[2]) > 6.0f)) {
#pragma unroll
                    for (int r = 0; r < 3; ++r) {
                        const float mx = rmax4(a[r]);
                        const float delta = mx > 6.0f ? mx : 0.f;
                        m[r] += delta; cmo[r] -= delta; l[r] *= ex2(-delta);
#pragma unroll
                        for (int k2 = 0; k2 < 2; ++k2) st[r][k2] = st[r][k2] - delta;
                    }
                }
#pragma unroll
                for (int r = 0; r < 3; ++r) {
                    float ps = 0.f;
#pragma unroll
                    for (int k2 = 0; k2 < 2; ++k2)
#pragma unroll
                        for (int e = 0; e < 4; ++e) ps += ex2(st[r][k2][e]);
                    l[r] += ps;
                }
            }
        }
    }
    float invl[3];
#pragma unroll
    for (int r = 0; r < 3; ++r) { float s = l[r]; s += __shfl_xor(s, 16); s += __shfl_xor(s, 32); invl[r] = s > 0.f ? -(m[r] + __builtin_amdgcn_logf(s)) : NEG; }
    __syncthreads();
    f32x4 O[3][4];
#pragma unroll
    for (int r = 0; r < 3; ++r)
#pragma unroll
        for (int dt = 0; dt < 4; ++dt) O[r][dt] = (f32x4){0.f, 0.f, 0.f, 0.f};
    for (int Tt = 0; Tt < nT; ++Tt) {
        if (1024 * Tt + 31 <= tqmax) {
            const LAS unsigned char* Kl = lds + OFF_K + Tt * TILE_B; const LAS unsigned char* Vl = lds + OFF_V + Tt * TILE_B;
            const int crel = 16 * (64 * Tt + 4 * fq) - tq;
            const bool full = 16 * (64 * Tt + 63) + 31 <= tqmin;
            const float cb = (float)(1024 * Tt - tq) + 15.5f;
            const int sw = fr & 7;
            float cfin[3];
#pragma unroll
            for (int r = 0; r < 3; ++r) cfin[r] = sl2[r] * cb + invl[r];
#pragma unroll 1
            for (int hf = 0; hf < 2; ++hf) {
                f32x4 st[3][2]; qk_half(st, Kl, QL, qaw16, kaw, hf, cfin, fr, fq);
                float ia[2] = {0.f, 0.f}, ib[2] = {0.f, 0.f};
                bf16x8 vf[4];
#pragma unroll
                for (int dt = 0; dt < 4; ++dt) {
                    const LAS unsigned char* vrow = Vl + (16 * dt + fr) * KSTR + 8 * (fq & 1);
                    const u32x2 v0 = *(const LAS u32x2*)(vrow + (((4 * hf + (fq >> 1)) ^ sw) << 4)), v1 = *(const LAS u32x2*)(vrow + (((4 * hf + 2 + (fq >> 1)) ^ sw) << 4));
                    u32x4 w; w.x = v0.x; w.y = v0.y; w.z = v1.x; w.w = v1.y;
                    vf[dt] = __builtin_bit_cast(bf16x8, w);
                }
#pragma unroll
                for (int r = 0; r < 3; ++r) {
#pragma unroll
                    for (int k2 = 0; k2 < 2; ++k2) {
                        if (full) {
#pragma unroll
                            for (int e = 0; e < 4; ++e) st[r][k2][e] = ex2(st[r][k2][e]);
                        } else {
#pragma unroll
                            for (int e = 0; e < 4; ++e) st[r][k2][e] = (crel + 512 * hf + 256 * k2 + 16 * e + 31 <= 0) ? ex2(st[r][k2][e]) : 0.f;
                        }
                        ia[k2] += (st[r][k2][0] + st[r][k2][1]) + (st[r][k2][2] + st[r][k2][3]); ib[k2] += st[r][k2][3];
                    }
                    u32x4 w; w.x = pk2(st[r][0][0], st[r][0][1]); w.y = pk2(st[r][0][2], st[r][0][3]); w.z = pk2(st[r][1][0], st[r][1][1]); w.w = pk2(st[r][1][2], st[r][1][3]);
                    const bf16x8 pb = __builtin_bit_cast(bf16x8, w);
#pragma unroll
                    for (int dt = 0; dt < 4; ++dt) O[r][dt] = MFMA16(vf[dt], pb, O[r][dt]);
                }
                LAS float* ip = IMP + (16 * w + fr) * 65 + 16 * Tt + 8 * hf + fq;
#pragma unroll
                for (int k2 = 0; k2 < 2; ++k2) {
                    __hip_atomic_fetch_add(ip + 4 * k2, ia[k2], __ATOMIC_RELAXED, __HIP_MEMORY_SCOPE_WORKGROUP);
                    if (16 * Tt + 8 * hf + 4 * k2 + fq + 1 < 64) __hip_atomic_fetch_add(ip + 4 * k2 + 1, ib[k2], __ATOMIC_RELAXED, __HIP_MEMORY_SCOPE_WORKGROUP);
                }
            }
        }
    }
#pragma unroll
    for (int r = 0; r < 3; ++r) { const float gc = gp[3 * r + 0];
#pragma unroll
        for (int dt = 0; dt < 4; ++dt) p.scr[(r * 4 + dt) * 512] = O[r][dt] * gc; }
    __syncthreads();
    {
        const int tok = tid >> 2, qd = tid & 3, cur = iq;
        unsigned long long mask;
        if (cur < 8) mask = (2ull << cur) - 1ull;
        else {
            mask = 1ull | (1ull << cur) | (1ull << (cur - 1));
            float v[16];
#pragma unroll
            for (int jj = 0; jj < 16; ++jj) { const int j = 16 * qd + jj; const float x = IMP[tok * 65 + j]; v[jj] = (j <= cur && j != 0 && j != cur && j != cur - 1) ? x : -1.0f; }
#pragma unroll 1
            for (int rd = 0; rd < 5; ++rd) {
                float bv = v[0]; int bj = 16 * qd;
#pragma unroll
                for (int jj = 1; jj < 16; ++jj) if (v[jj] > bv) { bv = v[jj]; bj = 16 * qd + jj; }
#pragma unroll
                for (int o = 1; o <= 2; o <<= 1) {
                    const int bvb = __builtin_bit_cast(int, bv);
                    const float ov = __builtin_bit_cast(float, o == 1 ? __builtin_amdgcn_update_dpp(bvb, bvb, 0xB1, 0xF, 0xF, true) : __builtin_amdgcn_update_dpp(bvb, bvb, 0x4E, 0xF, 0xF, true));
                    const int oj = o == 1 ? __builtin_amdgcn_update_dpp(bj, bj, 0xB1, 0xF, 0xF, true) : __builtin_amdgcn_update_dpp(bj, bj, 0x4E, 0xF, 0xF, true);
                    if (ov > bv || (ov == bv && oj < bj)) { bv = ov; bj = oj; } }
                if (bv >= 0.f) mask |= 1ull << bj;
#pragma unroll
                for (int jj = 0; jj < 16; ++jj) if (16 * qd + jj == bj) v[jj] = -1.0f;
            }
        }
        if (qd == 0) { SELM[tok * 2] = (unsigned)mask; SELM[tok * 2 + 1] = (unsigned)(mask >> 32); }
    }
    __syncthreads();
    const unsigned selLo = SELM[(16 * w + fr) * 2], selHi = SELM[(16 * w + fr) * 2 + 1];
    unsigned wlo = selLo, whi = selHi;
#pragma unroll
    for (int o = 1; o <= 8; o <<= 1) { wlo |= __shfl_xor(wlo, o); whi |= __shfl_xor(whi, o); }
    wlo = __builtin_amdgcn_readfirstlane(wlo); whi = __builtin_amdgcn_readfirstlane(whi);
    if (lane == 0) { __hip_atomic_fetch_or(BUN, wlo, __ATOMIC_RELAXED, __HIP_MEMORY_SCOPE_WORKGROUP); __hip_atomic_fetch_or(BUN + 1, whi, __ATOMIC_RELAXED, __HIP_MEMORY_SCOPE_WORKGROUP); }
    __syncthreads();
    const unsigned long long bun = (unsigned long long)__builtin_amdgcn_readfirstlane(BUN[0]) | ((unsigned long long)__builtin_amdgcn_readfirstlane(BUN[1]) << 32);
    const unsigned long long wun = (unsigned long long)wlo | ((unsigned long long)whi << 32);
    const unsigned long long selm = (unsigned long long)selLo | ((unsigned long long)selHi << 32);
    f32x4 O5[3][5];
    {
        const bf16* Kp = (const bf16*)(p.ws + WS_KS) + (size_t)bg * T * 64; const bf16* Vp = (const bf16*)(p.ws + WS_VST) + (size_t)bg * 64 * T;
#pragma unroll
        for (int r = 0; r < 3; ++r) { m[r] = M0REF;
#pragma unroll
            for (int dt = 0; dt < 5; ++dt) O5[r][dt] = (f32x4){0.f, 0.f, 0.f, 0.f}; }
        unsigned long long rem = bun; int cur = 0, ja, jb = -1;
        asm volatile("s_waitcnt vmcnt(0)" ::: "memory");
        ATT_POP(rem, ja); ATT_DMA(0, Kp + (size_t)ja * 64 * 64, Vp + ja * 64, T);
        if (rem) { ATT_POP(rem, jb); ATT_DMA(1, Kp + (size_t)jb * 64 * 64, Vp + jb * 64, T); }
        while (ja >= 0) {
            ATT_WAIT_SYNC();
            int na = -1, nb = -1;
            if (rem) { ATT_POP(rem, na); ATT_DMA(cur ^ 2, Kp + (size_t)na * 64 * 64, Vp + na * 64, T); }
            if (rem) { ATT_POP(rem, nb); ATT_DMA((cur ^ 2) + 1, Kp + (size_t)nb * 64 * 64, Vp + nb * 64, T); }
            if ((wun >> ja) & 1ull) {
                const bool selb = ((selm >> ja) & 1ull) != 0ull;
                const bool nm = (ja == iq) || !__all(selb);
                flash_step<0>(lds + OFF_K + cur * TILE_B, lds + OFF_V + cur * TILE_B, QL, qaw, kaw, sl2, 64 * ja + 4 * fq - tq, 64 * ja - tq, selb, nm, m, O5, fr, fq);
            }
            if (jb >= 0 && ((wun >> jb) & 1ull)) {
                const bool selb = ((selm >> jb) & 1ull) != 0ull;
                const bool nm = (jb == iq) || !__all(selb);
                flash_step<0>(lds + OFF_K + (cur + 1) * TILE_B, lds + OFF_V + (cur + 1) * TILE_B, QL, qaw, kaw, sl2, 64 * jb + 4 * fq - tq, 64 * jb - tq, selb, nm, m, O5, fr, fq);
            }
            ja = na; jb = nb; cur ^= 2;
        }
#pragma unroll
        for (int r = 0; r < 3; ++r) { const float s = __shfl(O5[r][4][0], fr); const float sc = gp[3 * r + 1] / s;
#pragma unroll
            for (int dt = 0; dt < 4; ++dt) p.scr[(12 + r * 4 + dt) * 512] = O5[r][dt] * sc; }
    }
    __syncthreads();
    {
        const bf16* Kp = (const bf16*)(p.ws + WS_KW) + (size_t)bg * T * 64; const bf16* Vp = (const bf16*)(p.ws + WS_VWT) + (size_t)bg * 64 * T;
#pragma unroll
        for (int r = 0; r < 3; ++r) { m[r] = M0REF;
#pragma unroll
            for (int dt = 0; dt < 5; ++dt) O5[r][dt] = (f32x4){0.f, 0.f, 0.f, 0.f}; }
        const int jlo = (2 * I - 8) > 0 ? (2 * I - 8) : 0, jhi = 2 * I + 1;
        asm volatile("s_waitcnt vmcnt(0)" ::: "memory");
        ATT_DMA(0, Kp + (size_t)jhi * 64 * 64, Vp + jhi * 64, T);
        if (jhi - 1 >= jlo) ATT_DMA(1, Kp + (size_t)(jhi - 1) * 64 * 64, Vp + (jhi - 1) * 64, T);
        int cur = 0;
        for (int j = jhi; j >= jlo; j -= 2) {
            ATT_WAIT_SYNC();
            if (j - 2 >= jlo) ATT_DMA(cur ^ 2, Kp + (size_t)(j - 2) * 64 * 64, Vp + (j - 2) * 64, T);
            if (j - 3 >= jlo) ATT_DMA((cur ^ 2) + 1, Kp + (size_t)(j - 3) * 64 * 64, Vp + (j - 3) * 64, T);
            if (j >= iq - 8 && j <= iq)
                flash_step<1>(lds + OFF_K + cur * TILE_B, lds + OFF_V + cur * TILE_B, QL, qaw, kaw, sl2, 64 * j + 4 * fq - tq, 64 * j - tq, true, (j == iq) || (j == iq - 8), m, O5, fr, fq);
            const int jj = j - 1;
            if (jj >= jlo && jj >= iq - 8 && jj <= iq)
                flash_step<1>(lds + OFF_K + (cur + 1) * TILE_B, lds + OFF_V + (cur + 1) * TILE_B, QL, qaw, kaw, sl2, 64 * jj + 4 * fq - tq, 64 * jj - tq, true, (jj == iq) || (jj == iq - 8), m, O5, fr, fq);
            cur ^= 2;
        }
        if (nI >= 0) ATT_QDMA(nbg >> 2, nbg & 3, nI);
#pragma unroll
        for (int r = 0; r < 3; ++r) { const float s = __shfl(O5[r][4][0], fr); const float sc = gp[3 * r + 2] / s;
#pragma unroll
            for (int dt = 0; dt < 4; ++dt) {
                const f32x4 v = (p.scr[(r * 4 + dt) * 512] + p.scr[(12 + r * 4 + dt) * 512]) + O5[r][dt] * sc;
                *(unsigned long long*)((bf16*)(p.ws + WS_XN) + row * D + 256 + (3 * g + r) * 64 + 16 * dt + 4 * fq) = (unsigned long long)pk2(v[0], v[1]) | ((unsigned long long)pk2(v[2], v[3]) << 32);
            } }
    }
    __syncthreads();
}

__device__ __forceinline__ void attn_decode(int L, int G, int& bg, int& I) {
    if (G == 256) {
        const int v = L & 255, i = L >> 8, c = v >> 3, s = c & 7, q = c >> 3, ii = (i + q) & 3;
        bg = (v & 7) * 4 + i; I = (ii == 0) ? s : (ii == 1) ? 15 - s : (ii == 2) ? 16 + s : 31 - s; }
    else { bg = L >> 5; I = L & 31; }
}
__device__ __forceinline__ void attn_phase(LAS unsigned char* lds, const P& p, int blk, int G) {
    bool first = true;
    for (int L = blk; L < 1024; L += G) {
        int bg, I, nbg = 0, nI = -1;
        attn_decode(L, G, bg, I);
        if (L + G < 1024) attn_decode(L + G, G, nbg, nI);
        attn_item(lds, p, bg >> 2, bg & 3, I, first, nbg, nI);
        first = false;
    }
}
}
#define XB_TMO      128
#define XB_XCNT(j)  (256  + 64 * (j))
#define XB_XSUB(j)  (1280 + 64 * (j))
#define XB_XGEN(j)  (2304 + 64 * (j))
#define XB_TOP      3328
#define XB_TOPGEN   3392
#define XCD_BAR_WORDS 3456
#define XB_SPIN_CAP (1u << 18)

__device__ __forceinline__ unsigned xb_ld(unsigned* p)              { return __hip_atomic_load(p, __ATOMIC_RELAXED, __HIP_MEMORY_SCOPE_AGENT); }
__device__ __forceinline__ unsigned xb_add(unsigned* p, unsigned v) { return __hip_atomic_fetch_add(p, v, __ATOMIC_RELAXED, __HIP_MEMORY_SCOPE_AGENT); }
__device__ __forceinline__ unsigned xb_xcc_id() { return (unsigned)__builtin_amdgcn_s_getreg((3 << 11) | 20) & 0xFu; }
#define XB_SPIN(cond, bar) do { unsigned _sp = 0; while (cond) { __builtin_amdgcn_s_sleep(1); \
    if ((++_sp & 255u) == 0u) { if (xb_ld(&(bar)[XB_TMO])) break; if (_sp > XB_SPIN_CAP) { atomicAdd(&(bar)[XB_TMO], 1u); break; } } } } while (0)

struct XcdBarrier {
    unsigned* bar; unsigned x;
    volatile LAS unsigned* st;
};

__device__ __forceinline__ XcdBarrier xcd_barrier_post(unsigned* bar, volatile LAS unsigned* st) {
    XcdBarrier b; b.bar = bar; b.x = xb_xcc_id(); b.st = st;
    if (threadIdx.x == 0) (void)xb_add(&bar[XB_XCNT(b.x)], 1u);
    return b;
}
__device__ __forceinline__ void xcd_barrier_complete(unsigned* bar, unsigned x, unsigned& nloc, unsigned& nx) {
    const unsigned G = gridDim.x * gridDim.y * gridDim.z;
    unsigned sum, cnt, mine, sp = 0u;
    for (;;) {
        sum = 0u; cnt = 0u; mine = 0u;
#pragma unroll
        for (unsigned j = 0; j < 16; ++j) { const unsigned c = xb_ld(&bar[XB_XCNT(j)]); sum += c; cnt += (c > 0u) ? 1u : 0u; mine = (j == x) ? c : mine; }
        if (sum == G) break;
        __builtin_amdgcn_s_sleep(1);
        if ((++sp & 255u) == 0u) { if (xb_ld(&bar[XB_TMO])) break; if (sp > XB_SPIN_CAP) { atomicAdd(&bar[XB_TMO], 1u); break; } }
    }
    nloc = mine > 0u ? mine : 1u; nx = cnt > 0u ? cnt : 1u;
}

__device__ __forceinline__ void xcd_barrier(const XcdBarrier& b) {
    asm volatile("s_waitcnt vmcnt(0)" ::: "memory");
    __syncthreads();
    if (threadIdx.x == 0) {
        unsigned* bar = b.bar;
        __builtin_amdgcn_s_waitcnt(0);
        unsigned nloc = b.st[0], nx = b.st[1];
        if (nloc == 0u) { xcd_barrier_complete(bar, b.x, nloc, nx); b.st[0] = nloc; b.st[1] = nx; }
        const unsigned old = xb_add(&bar[XB_XSUB(b.x)], 1u);
        const unsigned gen = old / nloc;
        if (old + 1u == (gen + 1u) * nloc) {
            __builtin_amdgcn_fence(__ATOMIC_RELEASE, "agent");
            asm volatile("s_waitcnt vmcnt(0)" ::: "memory");
            const unsigned og = xb_add(&bar[XB_TOP], 1u);
            const unsigned tg = og / nx;
            if (og + 1u == (tg + 1u) * nx) xb_add(&bar[XB_TOPGEN], 1u);
            else XB_SPIN(xb_ld(&bar[XB_TOPGEN]) == tg, bar);
            __builtin_amdgcn_fence(__ATOMIC_ACQUIRE, "agent");
            xb_add(&bar[XB_XGEN(b.x)], 1u);
            asm volatile("s_waitcnt vmcnt(0)" ::: "memory");
        } else {
            XB_SPIN(xb_ld(&bar[XB_XGEN(b.x)]) == gen, bar);
            __builtin_amdgcn_fence(__ATOMIC_ACQUIRE, "agent");
            asm volatile("s_waitcnt vmcnt(0)" ::: "memory");
        }
    }
    __syncthreads();
}

__global__ void __launch_bounds__(512, 2) hymba_fwd(Args args) {
    extern __shared__ __attribute__((aligned(16))) unsigned char lds_raw[];
    LAS unsigned char* lds = (LAS unsigned char*)lds_raw;
    cg::grid_group grid = cg::this_grid();
    const int G = gridDim.x;
    {
        LAS unsigned long long* ptw = (LAS unsigned long long*)(lds + MISC_OFF + 64);
        if (threadIdx.x == 0) {
#pragma unroll
            for (int i = 0; i < 18; ++i) ptw[i] = (unsigned long long)args.in[i];
            ptw[18] = (unsigned long long)args.out; ptw[19] = (unsigned long long)args.ws;
        }
    }
    const int ph_lo = args.ph_lo, ph_hi = args.ph_hi;
    if (threadIdx.x < 8) ((LAS unsigned*)(lds + MISC_OFF))[threadIdx.x] = 0u;
    __syncthreads();
    XcdBarrier xbar = xcd_barrier_post((unsigned*)(args.ws + WS_CTL), (volatile LAS unsigned*)(lds + MISC_OFF));
    bool first_sync = (ph_lo < 0);
#ifndef USE_CG_SYNC
#define USE_CG_SYNC 0
#endif
#ifndef PROBE_DUP_MASK
#define PROBE_DUP_MASK 0
#endif
#ifndef PROBE_DUP_SYNC
#define PROBE_DUP_SYNC 0
#endif
    for (int ph2 = ph_lo * 2; ph2 < ph_hi * 2; ++ph2) {
        const int ph = ph2 >> 1;
        const int layer = ph / NPH, k = ph % NPH;
        if ((ph2 & 1) && !((PROBE_DUP_MASK >> k & 1) && ph != DEPTH * NPH)) continue;
        int blk = blockIdx.x; asm volatile("" : "+s"(blk));
        PT a; a.t = (LAS const unsigned long long*)(lds + MISC_OFF + 64); a.ap = &args; a.ws = (unsigned char*)a.raw(19);
        unsigned char* ws = a.ws; float* X = (float*)(ws + WS_X); bf16* XN = (bf16*)(ws + WS_XN);
        const float* xin = layer == 0 ? a.in(0) : X;
        unsigned char* wset = ws + WS_WSET + (size_t)(layer & 1) * WSET_BYTES;
        bf16* XB = (bf16*)(ws + WS_XB); float* RSQ1 = (float*)(ws + WS_RSQ); float* RSQ2 = RSQ1 + (size_t)M * 16;
        if (ph != DEPTH * NPH && ((k == 0 && layer > 0) || k == 8)) continue;
        if (ph == DEPTH * NPH) {
            final_rows(XB, RSQ1, a.in(17), (float*)a.raw(18), blk, G);
        } else if (k == 0) {
            prologue_layer(a, 0, lds, blk, G);
            first_rows(xin, XB, RSQ1, blk, G);
        } else if (k == 1) {
            pg8::Gemm g{XB, (const bf16*)(wset + OFF_WIN), M, 2560, D}; pg8::StaticOrder S; S.init(M, 2560, G, blk);
            LAS float* RS = (LAS float*)(lds + 131072); pg8::prep_rstd(S, RSQ1, RS, my_tid());
            pg8::EpiWin E{(bf16*)(ws + WS_ACONV), (bf16*)(ws + WS_Q), (bf16*)(ws + WS_KCR), (bf16*)(ws + WS_VCR), (bf16*)(ws + WS_KS), (bf16*)(ws + WS_KW), (float*)(ws + WS_G), RS};
            pg8::gemm_phase<pg8::EpiWin, pg8::StaticOrder, true, true, false>(lds, g, S, E);
        } else if (k == 2) {
            pg8::Gemm g{XB, (const bf16*)(wset + OFF_WIN) + (size_t)2560 * D, M, 512, D}; pg8::StaticOrder S; S.init(M, 512, G, blk);
            LAS float* RS = (LAS float*)(lds + 131072); pg8::prep_rstd(S, RSQ1, RS, my_tid());
            pg8::EpiVT E{(bf16*)(ws + WS_VST), (bf16*)(ws + WS_VWT), RS};
            pg8::gemm_phase<pg8::EpiVT, pg8::StaticOrder, true, true, true>(lds, g, S, E);
        } else if (k == 3) {
            pg8::Gemm g{(const bf16*)(ws + WS_KCR), (const bf16*)(wset + OFF_CMPW), 16384, 1024, D}; pg8::CmpOrder S{G, blk};
            pg8::EpiCmp E{(float*)(ws + WS_LOHI)};
            pg8::gemm_phase<pg8::EpiCmp, pg8::CmpOrder, true, true, false>(lds, g, S, E);
        } else if (k == 4) {
            conv_phase(a, layer, lds, blk, G);
        } else if (k == 5) {
            cmp2_phase(a, layer, lds, blk, G);
            if (layer + 1 < DEPTH) { __syncthreads(); prologue_layer(a, layer + 1, lds, blk, G); }
        } else if (k == 6) {
            att::P p{ws, (f32x4*)(ws + WS_ASCR) + (size_t)blk * (24 * 512) + my_tid()};
            att::attn_phase(lds, p, blk, G);
        } else if (k == 7) {
            pg8::Gemm g{XN, (const bf16*)(wset + OFF_WOUT), M, D, D}; pg8::StaticOrder S; S.init(M, D, G, blk);
            pg8::EpiRes E{XB, RSQ2};
            pg8::gemm_phase<pg8::EpiRes, pg8::StaticOrder, true, true, false>(lds, g, S, E);
        } else if (k == 9) {
            pg8::Gemm g{XB, (const bf16*)(wset + OFF_WGU), M, 2 * DFF, D}; pg8::StaticOrder S; S.init(M, 2 * DFF, G, blk);
            LAS float* RS = (LAS float*)(lds + 131072); pg8::prep_rstd(S, RSQ2, RS, my_tid());
            pg8::EpiSwiglu E{(bf16*)(ws + WS_HFF), RS};
            pg8::gemm_phase<pg8::EpiSwiglu, pg8::StaticOrder, true, true, false>(lds, g, S, E);
        } else {
            pg8::Gemm g{(const bf16*)(ws + WS_HFF), (const bf16*)(wset + OFF_WD), M, D, DFF}; pg8::StaticOrder S; S.init(M, D, G, blk);
            pg8::EpiRes E{XB, RSQ1};
            pg8::gemm_phase<pg8::EpiRes, pg8::StaticOrder, true, true, false>(lds, g, S, E);
        }
        if (ph2 + 1 < ph_hi * 2) { if ((k == 1 || k == 3) && !(PROBE_DUP_MASK >> k & 1)) __syncthreads(); else { if (first_sync || USE_CG_SYNC) { grid.sync(); first_sync = false; } else xcd_barrier(xbar); if (PROBE_DUP_SYNC) xcd_barrier(xbar); } }
    }
}

#ifndef MULTI_LAUNCH
#define MULTI_LAUNCH 0
#endif
extern "C" void kernel_launch(void* const* d_in, const int* in_sizes, int n_in, void* d_out, int out_size, void* d_ws, size_t ws_size, hipStream_t stream) {
    static int grid = 0;
    if (grid == 0) {
        if (n_in != 18 || out_size != M * D || ws_size < WS_END) { fprintf(stderr, "kernel_launch: unexpected shapes: n_in %d out %d ws %zu (need %zu)\n", n_in, out_size, ws_size, (size_t)WS_END); grid = -1; return; }
        int dev = 0, cus = 0, per_cu = 0;
        (void)hipGetDevice(&dev);
        (void)hipDeviceGetAttribute(&cus, hipDeviceAttributeMultiprocessorCount, dev);
        (void)hipFuncSetAttribute((const void*)hymba_fwd, hipFuncAttributeMaxDynamicSharedMemorySize, LDS_BYTES);
        (void)hipOccupancyMaxActiveBlocksPerMultiprocessor(&per_cu, (const void*)hymba_fwd, 512, LDS_BYTES);
        fprintf(stderr, "kernel_launch: cus %d per_cu %d ws %zu\n", cus, per_cu, ws_size);
        if (per_cu < 1) { fprintf(stderr, "kernel_launch: occupancy query says 0 blocks per CU\n"); per_cu = 1; }
        grid = cus;
        (void)hipGetLastError();
    }
    if (grid < 0) return;
    (void)hipMemsetAsync((char*)d_ws + WS_CTL, 0, CTL_ZERO_BYTES, stream);
    Args a{};
    for (int i = 0; i < 18; ++i) a.in[i] = (const float*)d_in[i];
    a.out = (float*)d_out; a.ws = (unsigned char*)d_ws;
#if MULTI_LAUNCH
    for (int ph = 0; ph < NPHASES; ++ph) { a.ph_lo = ph; a.ph_hi = ph + 1; hipLaunchKernelGGL(hymba_fwd, dim3(grid), dim3(512), LDS_BYTES, stream, a); }
#else
    a.ph_lo = 0; a.ph_hi = NPHASES;
    void* args[] = {&a};
    hipError_t e = hipLaunchCooperativeKernel((const void*)hymba_fwd, dim3(grid), dim3(512), args, LDS_BYTES, stream);
    if (e != hipSuccess) fprintf(stderr, "kernel_launch: cooperative launch failed: %s (grid %d)\n", hipGetErrorString(e), grid);
#endif
}
```

```cpp
#include <hip/hip_runtime.h>
#include <hip/hip_cooperative_groups.h>
#include <cstdio>
#include <cstdint>
namespace cg = cooperative_groups;
__device__ __forceinline__ int my_tid() { int t = threadIdx.x; asm volatile("" : "+v"(t)); return t; }
namespace pg8 {
#define PG8_LAS __attribute__((address_space(3)))
typedef unsigned short bf16_t;
typedef short bf16x8 __attribute__((ext_vector_type(8)));
typedef float f32x4 __attribute__((ext_vector_type(4)));
typedef unsigned u32x4 __attribute__((ext_vector_type(4)));
constexpr int BM = 256, BK = 64, HALF = 128, HTB = HALF * BK * 2  , STAGE_BYTES = 8 * HTB, NXCD = 8, WGM = 8;

__host__ __device__ __forceinline__ int lds_byte(int r, int c) { const int st = (r >> 4) * 2 + (c >> 5), rr = r & 15, cc = c & 31, ob = rr * 64 + cc * 2; return st * 1024 + (ob ^ (((ob >> 9) & 1) << 5)); }
__host__ __device__ __forceinline__ void stage_rc(int b, int& R, int& C) { const int st = b / 1024, sb = b % 1024, swz = sb ^ (((sb >> 9) & 1) << 5); R = (st >> 1) * 16 + swz / 64; C = (st & 1) * 32 + (swz % 64) / 2; }
__host__ __device__ __forceinline__ int perm32(int rho) { const int n = rho >> 4, i = rho & 15; return 8 * (i >> 2) + 4 * n + (i & 3); }

struct Unit { int pm, pn, idx; };
struct Gemm { const bf16_t* A; const bf16_t* Bt; int M, N, K; };

struct StaticOrder {
    int nM, nN, nwg, G, c;
    __host__ __device__ void init(int M, int N, int G_, int c_) { nM = M / BM; nN = N / BM; nwg = nM * nN; G = G_; c = c_; }
    __host__ __device__ bool next(int i, Unit& u) const {
        const long L = (long)i * G + c; if (L >= nwg) return false;
        int wgid = (int)L; { const int q = nwg / NXCD, r = nwg % NXCD, xcd = wgid % NXCD, off = wgid / NXCD; wgid = (xcd < r ? xcd * (q + 1) : r * (q + 1) + (xcd - r) * q) + off; }
        const int nig = WGM * nN, gid = wgid / nig, fm = gid * WGM, gsz = (nM - fm) < WGM ? (nM - fm) : WGM;
        u.pm = fm + ((wgid % nig) % gsz); u.pn = (wgid % nig) / gsz; u.idx = i; return true;
    }
    __device__ __forceinline__ void a_ready(const Unit&) const {}
    __device__ __forceinline__ void done(const Unit&) const {}
};
typedef float f32x2_cvt __attribute__((ext_vector_type(2))); typedef __bf16 bf16x2_cvt __attribute__((ext_vector_type(2)));
__device__ __forceinline__ unsigned cvt_pk_bf16(float lo, float hi) { const f32x2_cvt v = {lo, hi}; const bf16x2_cvt b = __builtin_convertvector(v, bf16x2_cvt); return __builtin_bit_cast(unsigned, b); }
__device__ __forceinline__ float fast_sigmoid(float x) { return __builtin_amdgcn_rcpf(1.0f + __expf(-x)); }
__device__ __forceinline__ float fast_silu(float x) { return x * fast_sigmoid(x); }
constexpr float QSCALE2 = 0.125f * 1.4426950408889634f;

__device__ __forceinline__ float row_sumsq(const float* RSQ, int row) {
    const f32x4* p = (const f32x4*)(RSQ + (size_t)row * 16);
    const f32x4 a = p[0], b = p[1], c = p[2], d = p[3];
    const f32x4 t = (a + b) + (c + d);
    return (t[0] + t[1]) + (t[2] + t[3]);
}
__device__ __forceinline__ float row_rstd(const float* RSQ, int row) { return __builtin_amdgcn_rsqf(row_sumsq(RSQ, row) * (1.0f / 1024.0f) + 1e-6f); }
__device__ __forceinline__ float row_rstd4(const float* RSQ, int row, int fq) {
    const f32x4 a = *((const f32x4*)(RSQ + (size_t)row * 16) + fq);
    float t = (a[0] + a[1]) + (a[2] + a[3]);
    t += __shfl_xor(t, 16); t += __shfl_xor(t, 32);
    return __builtin_amdgcn_rsqf(t * (1.0f / 1024.0f) + 1e-6f);
}
struct EpiWin {
    static constexpr bool PERM = true, AFTER_DRAIN = false;
    bf16_t *ACONV, *Q, *KCR, *VCR, *KS, *KW; float* G; const PG8_LAS float* RS;
    __device__ __forceinline__ void operator()(const f32x4 (&acc)[2][2][4][2], const Unit& u, int wr, int wc, int fr, int fq) const {
        const int pn = u.pn;
        const int R0 = u.pm * BM + wr * 64 + fr, c0 = wc * 32 + 8 * fq;
        if (pn == 9) {
#pragma unroll
            for (int ai = 0; ai < 2; ++ai)
#pragma unroll
                for (int m = 0; m < 4; ++m) {
                    const float rs = RS[u.idx * 256 + wr * 64 + fr + ai * HALF + m * 16];
                    if (c0 < 36) {
                        float* gp = G + (size_t)(R0 + ai * HALF + m * 16) * 36 + c0;
                        const f32x4 v0 = acc[ai][0][m][0] * rs, v1 = acc[ai][0][m][1] * rs;
#pragma unroll
                        for (int e = 0; e < 4; ++e) { gp[e] = fast_sigmoid(v0[e]); if (c0 + 4 + e < 36) gp[4 + e] = fast_sigmoid(v1[e]); }
                    }
                }
            return;
        }
        bf16_t* P0; int SA, SM, SB; float sc = 1.0f;
        if (pn < 2) { P0 = ACONV + (size_t)R0 * 512 + pn * 256 + c0; SA = 128 * 512; SM = 16 * 512; SB = 128; }
        else if (pn < 5) { P0 = Q + (size_t)R0 * 768 + (pn - 2) * 256 + c0; SA = 128 * 768; SM = 16 * 768; SB = 128; sc = QSCALE2; }
        else if (pn < 7) { P0 = (pn == 5 ? KCR : VCR) + (size_t)(R0 >> 4) * 4096 + (R0 & 15) * 64 + (c0 >> 6) * 1024 + (c0 & 63); SA = 8 * 4096; SM = 4096; SB = 2 * 1024; }
        else { P0 = (pn == 7 ? KS : KW) + (size_t)(R0 >> 12) * (4 * 4096 * 64) + (size_t)(R0 & 4095) * 64 + (size_t)(c0 >> 6) * (4096 * 64) + (c0 & 63); SA = 128 * 64; SM = 16 * 64; SB = 2 * 4096 * 64; }
#pragma unroll
        for (int ai = 0; ai < 2; ++ai)
#pragma unroll
            for (int m = 0; m < 4; ++m) {
                const float rs = RS[u.idx * 256 + wr * 64 + fr + ai * HALF + m * 16] * sc;
#pragma unroll
                for (int bj = 0; bj < 2; ++bj) {
                    const f32x4 v0 = acc[ai][bj][m][0] * rs, v1 = acc[ai][bj][m][1] * rs;
                    u32x4 w; w.x = cvt_pk_bf16(v0[0], v0[1]); w.y = cvt_pk_bf16(v0[2], v0[3]); w.z = cvt_pk_bf16(v1[0], v1[1]); w.w = cvt_pk_bf16(v1[2], v1[3]);
                    *(u32x4*)(P0 + (size_t)ai * SA + (size_t)m * SM + (size_t)bj * SB) = w;
                }
            }
    }
};
struct EpiVT {
    static constexpr bool PERM = false, AFTER_DRAIN = false;
    bf16_t *VST, *VWT; const PG8_LAS float* RS;
    __device__ __forceinline__ void operator()(const f32x4 (&acc)[2][2][4][2], const Unit& u, int wr, int wc, int fr, int fq) const {
        bf16_t* base = u.pn == 0 ? VST : VWT;
#pragma unroll
        for (int ai = 0; ai < 2; ++ai)
#pragma unroll
            for (int m = 0; m < 4; ++m) {
                const int row = u.pm * BM + ai * HALF + wr * 64 + m * 16 + 4 * fq;
                const int b = row >> 12, t = row & 4095;
                const f32x4 rs4 = *(const PG8_LAS f32x4*)(RS + u.idx * 256 + ai * HALF + wr * 64 + m * 16 + 4 * fq);
#pragma unroll
                for (int bj = 0; bj < 2; ++bj)
#pragma unroll
                    for (int n = 0; n < 2; ++n) {
                        const int col = bj * HALF + wc * 32 + n * 16 + fr, g = col >> 6, d = col & 63;
                        const f32x4 v = acc[ai][bj][m][n] * rs4;
                        unsigned long long w = (unsigned long long)cvt_pk_bf16(v[0], v[1]) | ((unsigned long long)cvt_pk_bf16(v[2], v[3]) << 32);
                        *(unsigned long long*)(base + ((size_t)(b * 4 + g) * 64 + d) * 4096 + t) = w;
                    }
            }
    }
};
struct EpiRes {
    static constexpr bool PERM = false, AFTER_DRAIN = false;
    bf16_t* XB; float* RSQ;
    __device__ __forceinline__ void operator()(const f32x4 (&acc)[2][2][4][2], const Unit& u, int wr, int wc, int fr, int fq) const {
#pragma unroll
        for (int ai = 0; ai < 2; ++ai)
#pragma unroll
            for (int m = 0; m < 4; ++m) {
                const int row = u.pm * BM + ai * HALF + wr * 64 + m * 16 + fr;
                bf16_t* xp = XB + (size_t)row * 1024 + u.pn * BM + wc * 32 + 4 * fq;
                unsigned long long b[2][2];
#pragma unroll
                for (int bj = 0; bj < 2; ++bj)
#pragma unroll
                    for (int n = 0; n < 2; ++n) b[bj][n] = *(const unsigned long long*)(xp + bj * HALF + n * 16);
                float ss = 0.f;
#pragma unroll
                for (int bj = 0; bj < 2; ++bj)
#pragma unroll
                    for (int n = 0; n < 2; ++n) {
                        const unsigned lo = (unsigned)b[bj][n], hi = (unsigned)(b[bj][n] >> 32);
                        f32x4 v = acc[ai][bj][m][n];
                        v[0] += __builtin_bit_cast(float, lo << 16); v[1] += __builtin_bit_cast(float, lo & 0xffff0000u);
                        v[2] += __builtin_bit_cast(float, hi << 16); v[3] += __builtin_bit_cast(float, hi & 0xffff0000u);
                        ss += (v[0] * v[0] + v[1] * v[1]) + (v[2] * v[2] + v[3] * v[3]);
                        *(unsigned long long*)(xp + bj * HALF + n * 16) = (unsigned long long)cvt_pk_bf16(v[0], v[1]) | ((unsigned long long)cvt_pk_bf16(v[2], v[3]) << 32);
                    }
                ss += __shfl_xor(ss, 16); ss += __shfl_xor(ss, 32);
                if (fq == 0) RSQ[(size_t)row * 16 + u.pn * 4 + wc] = ss;
            }
    }
};
struct EpiSwiglu {
    static constexpr bool PERM = true, AFTER_DRAIN = false;
    bf16_t* H; const PG8_LAS float* RS;
    __device__ __forceinline__ void operator()(const f32x4 (&acc)[2][2][4][2], const Unit& u, int wr, int wc, int fr, int fq) const {
#pragma unroll
        for (int ai = 0; ai < 2; ++ai)
#pragma unroll
            for (int m = 0; m < 4; ++m) {
                const int row = u.pm * BM + ai * HALF + wr * 64 + m * 16 + fr;
                const float rs = RS[u.idx * 256 + ai * HALF + wr * 64 + m * 16 + fr];
                const f32x4 g0 = acc[ai][0][m][0] * rs, g1 = acc[ai][0][m][1] * rs, u0 = acc[ai][1][m][0] * rs, u1 = acc[ai][1][m][1] * rs;
                float r[8];
#pragma unroll
                for (int e = 0; e < 4; ++e) { r[e] = fast_silu(g0[e]) * u0[e]; r[4 + e] = fast_silu(g1[e]) * u1[e]; }
                u32x4 w; w.x = cvt_pk_bf16(r[0], r[1]); w.y = cvt_pk_bf16(r[2], r[3]); w.z = cvt_pk_bf16(r[4], r[5]); w.w = cvt_pk_bf16(r[6], r[7]);
                *(u32x4*)(H + (size_t)row * 2816 + u.pn * 128 + wc * 32 + 8 * fq) = w;
            }
    }
};
struct EpiCmp {
    static constexpr bool PERM = false, AFTER_DRAIN = false;
    float* LOHI;
    __device__ __forceinline__ void operator()(const f32x4 (&acc)[2][2][4][2], const Unit& u, int wr, int wc, int fr, int fq) const {
#pragma unroll
        for (int ai = 0; ai < 2; ++ai)
#pragma unroll
            for (int m = 0; m < 4; ++m) {
                const size_t off = (size_t)(u.pm * BM + ai * HALF + wr * 64 + m * 16 + fr) * 512 + (u.pn & 1) * BM + wc * 32 + 4 * fq;
#pragma unroll
                for (int bj = 0; bj < 2; ++bj)
#pragma unroll
                    for (int n = 0; n < 2; ++n) *(f32x4*)(LOHI + off + bj * HALF + n * 16) = acc[ai][bj][m][n];
            }
    }
};
template <class Sched>
__device__ __forceinline__ void prep_rstd(const Sched& S, const float* RSQ, PG8_LAS float* RS, int tid) {
    Unit u;
    for (int i = 0; S.next(i, u); ++i)
        if ((tid >> 8) == (i & 1)) RS[i * 256 + (tid & 255)] = row_rstd(RSQ, u.pm * BM + (tid & 255));
    __syncthreads();
}
struct CmpOrder {
    int G, c;
    __device__ bool next(int i, Unit& u) const {
        u.idx = i;
        if (G == 256) {
            if (i > 0 || (c >> 3) >= 16) return false;
            const int b = c & 7, q = c >> 3, kv = q >> 3; u.pm = kv * 32 + b * 4 + ((q >> 1) & 3); u.pn = kv * 2 + (q & 1); return true;
        }
        const long L = (long)i * G + c; if (L >= 128) return false; u.pm = (int)(L >> 1); u.pn = ((u.pm >= 32) ? 2 : 0) + (int)(L & 1); return true; }
    __device__ __forceinline__ void a_ready(const Unit&) const {}
    __device__ __forceinline__ void done(const Unit&) const {}
};
template <class Epi, class Sched, bool ALIGN_EPI = false, bool SP2 = false, bool SWAP = false>
__device__ __forceinline__ void gemm_phase(PG8_LAS unsigned char* lds, const Gemm g, const Sched& S, const Epi& E) {
    const int tid = my_tid(), wid = __builtin_amdgcn_readfirstlane(tid >> 6), lane = tid & 63, wr = wid >> 2, wc = wid & 3, fr = lane & 15, fq = lane >> 4;
    const int K = g.K, nt = K / BK;
    unsigned voffA[2], voffB[2];
#pragma unroll
    for (int i = 0; i < 2; ++i) { int R, C; stage_rc(tid * 16 + i * 8192, R, C); const int Rb = Epi::PERM ? ((R & ~31) + perm32(R & 31)) : R;
        voffA[i] = (unsigned)(R * K + C) * 2u; voffB[i] = (unsigned)(Rb * K + C) * 2u; }
    const size_t kstep = (size_t)(BK * 2);
    const size_t hstep = (size_t)HALF * K * 2;
    const size_t tstep = 2 * hstep;
    const unsigned ldsw = (unsigned)wid * 1024u;
    const int aoff = lds_byte(wr * 64 + fr, fq * 8), boff = lds_byte(wc * 32 + fr, fq * 8);
#define PG8_SA(b, h) (((b) * 2 + (h)) * HTB)
#define PG8_SB(b, h) ((4 + (b) * 2 + (h)) * HTB)
#define PG8_STAGE(bufoff, gbase, voff) do { _Pragma("unroll") for (int _i = 0; _i < 2; ++_i) \
        __builtin_amdgcn_global_load_lds((const unsigned*)((const char*)(gbase) + (voff)[_i]), (PG8_LAS unsigned*)(lds + (bufoff) + ldsw + _i * 8192), 16, 0, 0); } while (0)
#define PG8_LDA(dst, b, h) do { _Pragma("unroll") for (int m = 0; m < 4; ++m) _Pragma("unroll") for (int k = 0; k < 2; ++k) dst[m][k] = *(const PG8_LAS bf16x8*)(lds + PG8_SA(b, h) + aoff + m * 2048 + k * 1024); } while (0)
#define PG8_LDB(dst, b, h) do { _Pragma("unroll") for (int n = 0; n < 2; ++n) _Pragma("unroll") for (int k = 0; k < 2; ++k) dst[n][k] = *(const PG8_LAS bf16x8*)(lds + PG8_SB(b, h) + boff + n * 2048 + k * 1024); } while (0)
#define PG8_MMA(ai, bj, At, Bt) do { __builtin_amdgcn_s_setprio(1); _Pragma("unroll") for (int m = 0; m < 4; ++m) _Pragma("unroll") for (int n = 0; n < 2; ++n) _Pragma("unroll") for (int k = 0; k < 2; ++k) \
        acc[ai][bj][m][n] = SWAP ? __builtin_amdgcn_mfma_f32_16x16x32_bf16(At[m][k], Bt[n][k], acc[ai][bj][m][n], 0, 0, 0) : __builtin_amdgcn_mfma_f32_16x16x32_bf16(Bt[n][k], At[m][k], acc[ai][bj][m][n], 0, 0, 0); __builtin_amdgcn_s_setprio(0); } while (0)
#define PG8_WAIT_V(n) asm volatile("s_waitcnt vmcnt(" #n ")" ::: "memory")
#define PG8_WAIT_L(n) asm volatile("s_waitcnt lgkmcnt(" #n ")" ::: "memory")
#define PG8_BAR __builtin_amdgcn_s_barrier()
#define PG8_SCHED __builtin_amdgcn_sched_barrier(0)
    Unit cur, nxt; int ui = 0;
    if (!S.next(0, cur)) return;
    f32x4 acc[2][2][4][2];
#pragma unroll
    for (int a = 0; a < 2; ++a)
#pragma unroll
        for (int b = 0; b < 2; ++b)
#pragma unroll
            for (int m = 0; m < 4; ++m)
#pragma unroll
                for (int n = 0; n < 2; ++n) acc[a][b][m][n] = (f32x4){0.f, 0.f, 0.f, 0.f};
    bf16x8 At[4][2], B0[2][2], B1[2][2];
    const char* cA = (const char*)g.A + (size_t)cur.pm * tstep; const char* cB = (const char*)g.Bt + (size_t)cur.pn * tstep;
    S.a_ready(cur);
    if constexpr (SP2) {
        PG8_STAGE(PG8_SB(0, 0), cB, voffB); PG8_STAGE(PG8_SB(0, 1), cB + hstep, voffB); PG8_STAGE(PG8_SA(0, 0), cA, voffA); PG8_STAGE(PG8_SA(0, 1), cA + hstep, voffA);
        if (wr == 1) PG8_BAR;
        PG8_WAIT_V(2); PG8_BAR;
        PG8_STAGE(PG8_SB(1, 0), cB + kstep, voffB); PG8_STAGE(PG8_SA(1, 0), cA + kstep, voffA); PG8_STAGE(PG8_SB(1, 1), cB + hstep + kstep, voffB);
        PG8_WAIT_V(6); PG8_BAR;
    } else {
        PG8_STAGE(PG8_SB(0, 0), cB, voffB); PG8_STAGE(PG8_SA(0, 0), cA, voffA); PG8_STAGE(PG8_SB(0, 1), cB + hstep, voffB); PG8_STAGE(PG8_SA(0, 1), cA + hstep, voffA);
        if (wr == 1) PG8_BAR;
        PG8_WAIT_V(4); PG8_BAR;
        PG8_STAGE(PG8_SB(1, 0), cB + kstep, voffB); PG8_STAGE(PG8_SA(1, 0), cA + kstep, voffA); PG8_STAGE(PG8_SB(1, 1), cB + hstep + kstep, voffB);
        PG8_WAIT_V(6); PG8_BAR;
    }
    for (;;) {
        const bool has_next = S.next(ui + 1, nxt);
        const char* nA = has_next ? (const char*)g.A + (size_t)nxt.pm * tstep : cA; const char* nB = has_next ? (const char*)g.Bt + (size_t)nxt.pn * tstep : cB;
        for (int t = 0; t < nt; t += 2) {
            const bool last = (t == nt - 2);
            const char* a1 = cA + (size_t)(t + 1) * kstep;
            const char* a2 = last ? nA : cA + (size_t)(t + 2) * kstep; const char* b2 = last ? nB : cB + (size_t)(t + 2) * kstep;
            const char* a3 = a2 + kstep; const char* b3 = b2 + kstep;
            if (last && has_next) S.a_ready(nxt);
            if constexpr (SP2) {
            PG8_LDB(B0, 0, 0); PG8_LDB(B1, 0, 1); PG8_SCHED; PG8_LDA(At, 0, 0); PG8_STAGE(PG8_SA(1, 1), a1 + hstep, voffA);
            PG8_WAIT_V(8); PG8_WAIT_L(0); PG8_BAR; PG8_MMA(0, 0, At, B0); PG8_MMA(0, 1, At, B1); PG8_BAR; PG8_SCHED;
            PG8_LDA(At, 0, 1); PG8_STAGE(PG8_SB(0, 0), b2, voffB); PG8_STAGE(PG8_SB(0, 1), b2 + hstep, voffB); PG8_STAGE(PG8_SA(0, 0), a2, voffA);
            PG8_WAIT_V(8); PG8_WAIT_L(0); PG8_BAR; PG8_MMA(1, 0, At, B0); PG8_MMA(1, 1, At, B1); PG8_BAR; PG8_SCHED;
            PG8_LDB(B0, 1, 0); PG8_LDB(B1, 1, 1); PG8_SCHED; PG8_LDA(At, 1, 0); PG8_STAGE(PG8_SA(0, 1), a2 + hstep, voffA);
            PG8_WAIT_V(8); PG8_WAIT_L(0); PG8_BAR; PG8_MMA(0, 0, At, B0); PG8_MMA(0, 1, At, B1); PG8_BAR; PG8_SCHED;
            PG8_LDA(At, 1, 1); PG8_STAGE(PG8_SB(1, 0), b3, voffB); PG8_STAGE(PG8_SB(1, 1), b3 + hstep, voffB); PG8_STAGE(PG8_SA(1, 0), a3, voffA);
            PG8_WAIT_V(8); PG8_WAIT_L(0); PG8_BAR; PG8_MMA(1, 0, At, B0); PG8_MMA(1, 1, At, B1); PG8_BAR; PG8_SCHED;
            } else {
            PG8_LDB(B0, 0, 0); PG8_SCHED; PG8_LDA(At, 0, 0); PG8_STAGE(PG8_SA(1, 1), a1 + hstep, voffA);
            PG8_WAIT_L(8); PG8_BAR; PG8_WAIT_L(0); PG8_MMA(0, 0, At, B0); PG8_BAR; PG8_SCHED;
            PG8_LDB(B1, 0, 1); PG8_STAGE(PG8_SB(0, 0), b2, voffB);
            PG8_BAR; PG8_WAIT_L(0); PG8_MMA(0, 1, At, B1); PG8_BAR;
            PG8_LDA(At, 0, 1); PG8_STAGE(PG8_SA(0, 0), a2, voffA);
            PG8_BAR; PG8_WAIT_L(0); PG8_MMA(1, 0, At, B0); PG8_BAR; PG8_SCHED;
            PG8_STAGE(PG8_SB(0, 1), b2 + hstep, voffB);
            PG8_WAIT_V(6); PG8_BAR; PG8_MMA(1, 1, At, B1); PG8_BAR;
            PG8_LDB(B0, 1, 0); PG8_SCHED; PG8_LDA(At, 1, 0); PG8_STAGE(PG8_SA(0, 1), a2 + hstep, voffA);
            PG8_WAIT_L(8); PG8_BAR; PG8_WAIT_L(0); PG8_MMA(0, 0, At, B0); PG8_BAR; PG8_SCHED;
            PG8_LDB(B1, 1, 1); PG8_STAGE(PG8_SB(1, 0), b3, voffB);
            PG8_BAR; PG8_WAIT_L(0); PG8_MMA(0, 1, At, B1); PG8_BAR;
            PG8_LDA(At, 1, 1); PG8_STAGE(PG8_SA(1, 0), a3, voffA);
            PG8_BAR; PG8_WAIT_L(0); PG8_MMA(1, 0, At, B0); PG8_BAR; PG8_SCHED;
            PG8_STAGE(PG8_SB(1, 1), b3 + hstep, voffB);
            PG8_WAIT_V(6); PG8_BAR; PG8_MMA(1, 1, At, B1); PG8_BAR;
            }
        }
        if constexpr (ALIGN_EPI) { if (wr == 0) PG8_BAR; }
        if constexpr (!Epi::AFTER_DRAIN) { E(acc, cur, wr, wc, fr, fq); S.done(cur); }
        if (!has_next) break;
#pragma unroll
        for (int a = 0; a < 2; ++a)
#pragma unroll
            for (int b = 0; b < 2; ++b)
#pragma unroll
                for (int m = 0; m < 4; ++m)
#pragma unroll
                    for (int n = 0; n < 2; ++n) acc[a][b][m][n] = (f32x4){0.f, 0.f, 0.f, 0.f};
        cur = nxt; cA = nA; cB = nB; ++ui;
        if constexpr (ALIGN_EPI) { if (wr == 1) PG8_BAR; }
    }
    PG8_WAIT_V(0);
    if constexpr (!ALIGN_EPI) { if (wr == 0) PG8_BAR; }
    PG8_BAR;
    if constexpr (Epi::AFTER_DRAIN) { E.fused(acc, cur, wr, wc, fr, fq, lds, wid, lane); S.done(cur); }
#undef PG8_SA
#undef PG8_SB
#undef PG8_STAGE
#undef PG8_LDA
#undef PG8_LDB
#undef PG8_MMA
#undef PG8_WAIT_V
#undef PG8_WAIT_L
#undef PG8_BAR
#undef PG8_SCHED
}
}
#define LAS __attribute__((address_space(3)))
typedef unsigned short bf16;
typedef short bf16x8 __attribute__((ext_vector_type(8)));
typedef short s16x4 __attribute__((ext_vector_type(4)));
typedef float f32x4 __attribute__((ext_vector_type(4)));
typedef unsigned u32x4 __attribute__((ext_vector_type(4)));
typedef unsigned u32x2 __attribute__((ext_vector_type(2)));

constexpr int NB = 8, T = 4096, D = 1024, M = NB * T, DEPTH = 4;
constexpr int IN_COLS = 2852, DFF = 2816;
constexpr float EPS = 1e-6f;
constexpr float LOG2E = 1.4426950408889634f;
constexpr size_t MiB = 1u << 20;
constexpr size_t WS_X = 0, WS_XN = 128 * MiB, WS_ACONV = 192 * MiB, WS_Q = 224 * MiB, WS_KCR = 272 * MiB, WS_VCR = 288 * MiB, WS_KS = 304 * MiB, WS_KW = 320 * MiB,
                 WS_VST = 336 * MiB, WS_VWT = 352 * MiB, WS_HFF = 192 * MiB,
                 WS_WSET = 368 * MiB, WSET_BYTES = 27 * MiB,
                 OFF_WIN = 0, OFF_WOUT = 6 * MiB, OFF_WGU = 8 * MiB, OFF_WD = 19 * MiB, OFF_CMPW = 25 * MiB,
                 WS_XB = 422 * MiB, WS_LOHI = 0, WS_ASCR = 32 * MiB,
                 WS_G = 486 * MiB, WS_KC = 491 * MiB, WS_VCT = 492 * MiB, WS_PE = 493 * MiB, WS_RSQ = 494 * MiB, WS_CTL = 498 * MiB, WS_END = 499 * MiB;
constexpr int LDS_BYTES = 163840, MISC_OFF = 163840 - 512, CTL_ZERO_BYTES = 16384;
constexpr int NPH = 11, NPHASES = DEPTH * NPH + 1;

struct Args {
    const float* in[18]; float* out; unsigned char* ws; int ph_lo, ph_hi;
};
#ifndef USE_PT
#define USE_PT 0
#endif
struct PT {
    LAS const unsigned long long* t; unsigned char* ws; const Args* ap;
#if USE_PT
    __device__ __forceinline__ unsigned long long raw(int i) const { const unsigned long long v = t[i]; return (unsigned long long)__builtin_amdgcn_readfirstlane((unsigned)v) | ((unsigned long long)__builtin_amdgcn_readfirstlane((unsigned)(v >> 32)) << 32); }
#else
    __device__ __forceinline__ unsigned long long raw(int i) const { return i < 18 ? (unsigned long long)ap->in[i] : (i == 18 ? (unsigned long long)ap->out : (unsigned long long)ap->ws); }
#endif
    __device__ __forceinline__ const float* in(int i) const { return (const float*)raw(i); }
};

__device__ __forceinline__ unsigned f2bf(float f) { unsigned u = __builtin_bit_cast(unsigned, f); return (u + 0x7fffu + ((u >> 16) & 1u)) >> 16; }
typedef float f32x2_cv __attribute__((ext_vector_type(2))); typedef __bf16 bf16x2_cv __attribute__((ext_vector_type(2)));
__device__ __forceinline__ unsigned pk2(float lo, float hi) { const f32x2_cv v = {lo, hi}; const bf16x2_cv b = __builtin_convertvector(v, bf16x2_cv); return __builtin_bit_cast(unsigned, b); }
__device__ __forceinline__ float bf2f(unsigned short h) { return __builtin_bit_cast(float, (unsigned)h << 16); }
__device__ __forceinline__ float wave_sum(float v) {
#pragma unroll
    for (int o = 1; o < 64; o <<= 1) v += __shfl_xor(v, o);
    return v;
}
#define LDS_WAIT() asm volatile("s_waitcnt lgkmcnt(0)" ::: "memory")

__device__ __forceinline__ void transpose_item(const float* W, int ldw, int ncols, bf16* WTrow0, int ldt, LAS float* scr, int k0, int n0, int lane, const float* gain = nullptr) {
    const int cq = lane & 15, kr = lane >> 4;
#pragma unroll 8
    for (int i = 0; i < 16; ++i) {
        const int kk = 4 * i + kr, n = n0 + 4 * cq;
        f32x4 v = {0.f, 0.f, 0.f, 0.f};
        if (n < ncols) v = *(const f32x4*)(W + (size_t)(k0 + kk) * ldw + n);
        LAS float* d = scr + kk * 65 + 4 * cq;
        d[0] = v[0]; d[1] = v[1]; d[2] = v[2]; d[3] = v[3];
    }
    LDS_WAIT(); asm volatile("" ::: "memory");
    const int c = lane & 7;
    f32x4 ga = {1.f, 1.f, 1.f, 1.f}, gb = ga;
    if (gain) { ga = *(const f32x4*)(gain + k0 + 8 * c); gb = *(const f32x4*)(gain + k0 + 8 * c + 4); }
#pragma unroll
    for (int j = 0; j < 8; ++j) { const int n = (lane >> 3) + 8 * j; const LAS float* s = scr + (8 * c) * 65 + n;
        u32x4 o; o.x = pk2(s[0 * 65] * ga[0], s[1 * 65] * ga[1]); o.y = pk2(s[2 * 65] * ga[2], s[3 * 65] * ga[3]); o.z = pk2(s[4 * 65] * gb[0], s[5 * 65] * gb[1]); o.w = pk2(s[6 * 65] * gb[2], s[7 * 65] * gb[3]);
        *(u32x4*)(WTrow0 + (size_t)n * ldt + k0 + 8 * c) = o; }
    LDS_WAIT(); asm volatile("" ::: "memory");
}
__device__ __forceinline__ int win_row(int n0) {
    if (n0 < 2048) return n0;
    if (n0 < 2304) return 2560 + (n0 - 2048);
    if (n0 < 2560) return 2048 + (n0 - 2304);
    if (n0 < 2816) return 2816 + (n0 - 2560);
    return 2304 + (n0 - 2816);
}
__device__ __forceinline__ int wgu_row(int n0) { const int h = n0 < DFF ? n0 : n0 - DFF; return 256 * (h >> 7) + (h & 127) + (n0 < DFF ? 0 : 128); }

__device__ __forceinline__ void prologue_layer(const PT& a, int layer, LAS unsigned char* lds, int blk, int G) {
    const int tid = my_tid(), lane = tid & 63, wave = tid >> 6;
    LAS float* scr = (LAS float*)(lds + wave * 17408);
    const int gw = blk * 8 + wave, NGW = G * 8;
    unsigned char* ws = a.ws; unsigned char* wset = ws + WS_WSET + (size_t)(layer & 1) * WSET_BYTES;
    bf16* WIN = (bf16*)(wset + OFF_WIN); bf16* WOUT = (bf16*)(wset + OFF_WOUT); bf16* WGU = (bf16*)(wset + OFF_WGU); bf16* WD = (bf16*)(wset + OFF_WD); bf16* CMPW = (bf16*)(wset + OFF_CMPW);
    const float* g1 = a.in(1) + (size_t)layer * D; const float* g2 = a.in(14) + (size_t)layer * D;
    const float* w_in = a.in(2) + (size_t)layer * D * IN_COLS;
    const float* w_out = a.in(13) + (size_t)layer * D * D;
    const float* w_gu = a.in(15) + (size_t)layer * D * 2 * DFF;
    const float* w_dn = a.in(16) + (size_t)layer * DFF * D;
    const float* kw1 = a.in(8) + (size_t)layer * 32 * 64 * 256;
    const float* vw1 = a.in(11) + (size_t)layer * 32 * 64 * 256;
    constexpr int I_IN = 16 * 45, I_OUT = 16 * 16, I_GU = 16 * 88, I_DN = 44 * 16, I_C = 16 * 4;
    constexpr int NIT = I_IN + I_OUT + I_GU + I_DN + 4 * I_C;
    for (int it = gw; it < NIT; it += NGW) {
        int r = it;
        if (r < I_IN) { const int kb = r / 45, nb = r % 45; transpose_item(w_in, IN_COLS, IN_COLS, WIN + (size_t)win_row(64 * nb) * D, D, scr, 64 * kb, 64 * nb, lane, g1); continue; } r -= I_IN;
        if (r < I_OUT) { const int kb = r / 16, nb = r % 16; transpose_item(w_out, D, D, WOUT + (size_t)(64 * nb) * D, D, scr, 64 * kb, 64 * nb, lane); continue; } r -= I_OUT;
        if (r < I_GU) { const int kb = r / 88, nb = r % 88; transpose_item(w_gu, 2 * DFF, 2 * DFF, WGU + (size_t)wgu_row(64 * nb) * D, D, scr, 64 * kb, 64 * nb, lane, g2); continue; } r -= I_GU;
        if (r < I_DN) { const int kb = r / 16, nb = r % 16; transpose_item(w_dn, D, D, WD + (size_t)(64 * nb) * DFF, DFF, scr, 64 * kb, 64 * nb, lane); continue; } r -= I_DN;
        { const int q = r / I_C, rr = r % I_C, kb = rr / 4, nb = rr % 4;
          const float* src = ((q < 2) ? kw1 : vw1) + (size_t)(q & 1) * 1024 * 256;
          transpose_item(src, 256, 256, CMPW + (size_t)(q * 256 + 64 * nb) * D, D, scr, 64 * kb, 64 * nb, lane); }
    }
    { u32x4 z = {0u, 0u, 0u, 0u}; u32x4* p = (u32x4*)(WIN + (size_t)(2304 + 64) * D);
      for (int i = blk * 512 + tid; i < 192 * D / 8; i += G * 512) p[i] = z; }
    if (blk < 16) {
        __syncthreads();
        const int kvb = blk >> 3, cg = blk & 7;
        const float* pe = (kvb == 0 ? a.in(7) : a.in(10)) + (size_t)layer * 2048;
        const float* w1 = kvb == 0 ? kw1 : vw1;
        LAS float* red = (LAS float*)lds;
        const int c = tid & 31, lg = tid >> 5;
        float s = 0.f;
#pragma unroll 16
        for (int i = 0; i < 128; ++i) { const int ld = lg * 128 + i; s += pe[ld] * w1[(size_t)ld * 256 + cg * 32 + c]; }
        red[lg * 32 + c] = s;
        __syncthreads();
        if (tid < 32) { float t = 0.f;
#pragma unroll
            for (int j = 0; j < 16; ++j) t += red[j * 32 + tid];
            ((float*)(ws + WS_PE))[(layer & 1) * 512 + kvb * 256 + cg * 32 + tid] = t; }
        __syncthreads();
    }
}

__device__ __forceinline__ void first_rows(const float* x, bf16* XB, float* RSQ, int blk, int G) {
    const int tid = my_tid(), lane = tid & 63, wave = tid >> 6;
    const int gw = blk * 8 + wave, NGW = G * 8;
    for (int mi = gw; mi < M; mi += NGW) {
        const int m = (G == 256) ? ((blk & 7) * 4096 + (blk >> 3) * 8 + wave + 256 * (mi >> 11)) : mi;
        const f32x4* xr = (const f32x4*)(x + (size_t)m * D) + lane;
        unsigned long long* o8 = (unsigned long long*)(XB + (size_t)m * D) + lane;
        float s = 0.f;
#pragma unroll
        for (int j = 0; j < 4; ++j) { const f32x4 v = xr[64 * j]; s += (v.x * v.x + v.y * v.y) + (v.z * v.z + v.w * v.w); o8[64 * j] = (unsigned long long)pk2(v.x, v.y) | ((unsigned long long)pk2(v.z, v.w) << 32); }
        s = wave_sum(s);
        if (lane < 16) RSQ[(size_t)m * 16 + lane] = lane == 0 ? s : 0.f;
    }
}
__device__ __forceinline__ void final_rows(const bf16* xb, const float* RSQ, const float* gain, float* out, int blk, int G) {
    const int tid = my_tid(), lane = tid & 63, wave = tid >> 6;
    const int gw = blk * 8 + wave, NGW = G * 8;
    f32x4 gv[4];
#pragma unroll
    for (int j = 0; j < 4; ++j) gv[j] = *((const f32x4*)gain + lane + 64 * j);
    for (int mi = gw; mi < M; mi += NGW) {
        const int m = (G == 256) ? ((blk & 7) * 4096 + (blk >> 3) * 8 + wave + 256 * (mi >> 11)) : mi;
        const float rstd = 1.0f / sqrtf(pg8::row_sumsq(RSQ, m) * (1.f / D) + EPS);
        const unsigned long long* xr = (const unsigned long long*)(xb + (size_t)m * D) + lane;
        f32x4* o = (f32x4*)(out + (size_t)m * D) + lane;
#pragma unroll
        for (int j = 0; j < 4; ++j) {
            const unsigned long long w = xr[64 * j]; const unsigned lo = (unsigned)w, hi = (unsigned)(w >> 32);
            const f32x4 v = {__builtin_bit_cast(float, lo << 16), __builtin_bit_cast(float, lo & 0xffff0000u), __builtin_bit_cast(float, hi << 16), __builtin_bit_cast(float, hi & 0xffff0000u)};
            o[64 * j] = v * rstd * gv[j];
        }
    }
}

__device__ __forceinline__ void conv_phase(const PT& a, int layer, LAS unsigned char* lds, int blk, int G) {
    const int tid = my_tid(), lane = tid & 63, wave = tid >> 6;
    LAS float* Y = (LAS float*)lds;
    LAS float* C = Y + 62 * 256;
    const bf16* ACONV = (const bf16*)(a.ws + WS_ACONV);
    bf16* MIX = (bf16*)(a.ws + WS_XN);
    const float* cw = a.in(3) + (size_t)layer * 31 * 256;
    const float* cb = a.in(4) + (size_t)layer * 256;
    const float* lg = a.in(5) + (size_t)layer * 256;
    const float* lb = a.in(6) + (size_t)layer * 256;
    const int c = tid & 255, half = tid >> 8;
    float w[31];
#pragma unroll
    for (int k = 0; k < 31; ++k) w[k] = cw[k * 256 + c];
    const float bias = cb[c];
    const f32x4 g4 = *((const f32x4*)lg + lane), b4 = *((const f32x4*)lb + lane);
    const int cq = blk >> 3, cnt = (G == 256) ? (cq < 16 ? 1 : 7) : 0, tbase = (blk & 7) * 128 + (cq < 16 ? cq : 16 + 7 * (cq - 16));
    u32x4 ru[4], rv[4];
#define CONV_FETCH(tile_) do { const int b_ = (tile_) >> 7, t0_ = ((tile_) & 127) * 32; \
        _Pragma("unroll") for (int k_ = 0; k_ < 4; ++k_) { const int idx_ = tid + 512 * k_; const int t_ = t0_ - 30 + (idx_ >> 5); \
            ru[k_] = (u32x4){0u, 0u, 0u, 0u}; rv[k_] = ru[k_]; \
            if (idx_ < 62 * 32 && t_ >= 0) { const bf16* p_ = ACONV + ((size_t)b_ * T + t_) * 512 + (idx_ & 31) * 8; ru[k_] = *(const u32x4*)p_; rv[k_] = *(const u32x4*)(p_ + 256); } } } while (0)
    const int tl0 = (G == 256) ? 0 : blk, tlim = (G == 256) ? cnt : 1024, tstep = (G == 256) ? 1 : G;
    if (tl0 < tlim) CONV_FETCH((G == 256) ? tbase + tl0 : tl0);
    for (int tl = tl0; tl < tlim; tl += tstep) {
        const int tile = (G == 256) ? tbase + tl : tl;
        const int b = tile >> 7, t0 = (tile & 127) * 32;
#pragma unroll
        for (int k = 0; k < 4; ++k) {
            const int idx = tid + 512 * k;
            if (idx < 62 * 32) {
                const int rr = idx >> 5, ch = idx & 31;
                f32x4 y0, y1;
                const u32x4 u = ru[k], v = rv[k];
#pragma unroll
                for (int e = 0; e < 4; ++e) {
                    const float ulo = __builtin_bit_cast(float, u[e] << 16), uhi = __builtin_bit_cast(float, u[e] & 0xffff0000u);
                    const float vlo = __builtin_bit_cast(float, v[e] << 16), vhi = __builtin_bit_cast(float, v[e] & 0xffff0000u);
                    const float r0 = ulo * pg8::fast_sigmoid(vlo), r1 = uhi * pg8::fast_sigmoid(vhi);
                    if (e < 2) { y0[2 * e] = r0; y0[2 * e + 1] = r1; } else { y1[2 * (e - 2)] = r0; y1[2 * (e - 2) + 1] = r1; }
                }
                *(LAS f32x4*)(Y + rr * 256 + ch * 8) = y0; *(LAS f32x4*)(Y + rr * 256 + ch * 8 + 4) = y1;
            }
        }
        __syncthreads();
        if (tl + tstep < tlim) CONV_FETCH((G == 256) ? tbase + tl + tstep : tl + tstep);
        {
            float acc[16];
#pragma unroll
            for (int tt = 0; tt < 16; ++tt) acc[tt] = bias;
#pragma unroll
            for (int r2 = 0; r2 < 46; ++r2) {
                const float yv = Y[(half * 16 + r2) * 256 + c];
#pragma unroll
                for (int tt = 0; tt < 16; ++tt) { const int k = r2 - tt; if (k >= 0 && k <= 30) acc[tt] += w[k] * yv; }
            }
#pragma unroll
            for (int tt = 0; tt < 16; ++tt) C[(half * 16 + tt) * 256 + c] = acc[tt];
        }
        __syncthreads();
#pragma unroll
        for (int i = 0; i < 4; ++i) {
            const int tok = wave * 4 + i;
            const f32x4 v = *(const LAS f32x4*)(C + tok * 256 + lane * 4);
            const float mu = wave_sum((v.x + v.y) + (v.z + v.w)) * (1.f / 256.f);
            const f32x4 dv = v - mu;
            const float var = wave_sum((dv.x * dv.x + dv.y * dv.y) + (dv.z * dv.z + dv.w * dv.w)) * (1.f / 256.f);
            const float rstd = 1.0f / sqrtf(var + EPS);
            f32x4 y = dv * rstd * g4 + b4;
            y.x = pg8::fast_silu(y.x); y.y = pg8::fast_silu(y.y); y.z = pg8::fast_silu(y.z); y.w = pg8::fast_silu(y.w);
            *(unsigned long long*)(MIX + ((size_t)b * T + t0 + tok) * D + lane * 4) = (unsigned long long)pk2(y.x, y.y) | ((unsigned long long)pk2(y.z, y.w) << 32);
        }
    }
    __syncthreads();
}

__device__ __forceinline__ void cmp2_phase(const PT& a, int layer, LAS unsigned char* lds, int blk, int G) {
    const int tid = my_tid(), lane = tid & 63, wave = tid >> 6;
    LAS float* hL = (LAS float*)(lds + wave * 4096);
    LAS float* W2L = (LAS float*)(lds + 32768);
    const float* LOHI = (const float*)(a.ws + WS_LOHI);
    const float* PE = (const float*)(a.ws + WS_PE) + (layer & 1) * 512;
    bf16* KC = (bf16*)(a.ws + WS_KC); bf16* VCT = (bf16*)(a.ws + WS_VCT);
    const int gw = blk * 8 + wave, NGW = G * 8;
    const int nround = (G == 256) ? 2 : (2 * NB * 255 + NGW - 1) / NGW;
    for (int rd = 0; rd < nround; ++rd) {
        int kv, b, n; bool act;
        if (G == 256) {
            const int lw = (blk >> 3) * 8 + wave; kv = rd; b = blk & 7; n = lw; act = lw < 255;
            const float* w2g = (kv == 0 ? a.in(9) : a.in(12)) + (size_t)layer * 256 * 64;
            __syncthreads();
#pragma unroll
            for (int i = 0; i < 8; ++i) *(LAS f32x4*)(W2L + (tid + 512 * i) * 4) = *((const f32x4*)w2g + tid + 512 * i);
            __syncthreads();
        } else { const int gi = gw + rd * NGW; act = gi < 2 * NB * 255; kv = act ? gi / (NB * 255) : 0; const int rem = act ? gi % (NB * 255) : 0; b = rem / 255; n = rem % 255; }
        if (!act) continue;
        const float* w2 = (kv == 0 ? a.in(9) : a.in(12)) + (size_t)layer * 256 * 64;
        const f32x4 pe4 = *((const f32x4*)(PE + kv * 256) + lane);
#pragma unroll
        for (int g = 0; g < 4; ++g) {
            const size_t R0 = (size_t)kv * 8192 + ((size_t)b * 256 + n) * 4 + g, R1 = R0 + 4;
            const f32x4 lo = *((const f32x4*)(LOHI + R0 * 512) + lane), hi = *((const f32x4*)(LOHI + R1 * 512 + 256) + lane);
            f32x4 h = lo + hi + pe4;
            h.x = pg8::fast_silu(h.x); h.y = pg8::fast_silu(h.y); h.z = pg8::fast_silu(h.z); h.w = pg8::fast_silu(h.w);
            *(LAS f32x4*)(hL + g * 256 + lane * 4) = h;
        }
        LDS_WAIT(); asm volatile("" ::: "memory");
        float acc[4] = {0.f, 0.f, 0.f, 0.f};
#pragma unroll 4
        for (int j4 = 0; j4 < 64; ++j4) {
            float wv[4];
#pragma unroll
            for (int e = 0; e < 4; ++e) wv[e] = (G == 256) ? W2L[(4 * j4 + e) * 64 + lane] : w2[(4 * j4 + e) * 64 + lane];
#pragma unroll
            for (int g = 0; g < 4; ++g) { const f32x4 hv = *(const LAS f32x4*)(hL + g * 256 + 4 * j4); acc[g] += hv.x * wv[0] + hv.y * wv[1] + hv.z * wv[2] + hv.w * wv[3]; }
        }
        LDS_WAIT(); asm volatile("" ::: "memory");
#pragma unroll
        for (int g = 0; g < 4; ++g) {
            const unsigned short o = (unsigned short)f2bf(acc[g]);
            if (kv == 0) { KC[((size_t)(b * 4 + g) * 256 + n) * 64 + lane] = o; if (n == 254) KC[((size_t)(b * 4 + g) * 256 + 255) * 64 + lane] = 0; }
            else { VCT[((size_t)(b * 4 + g) * 64 + lane) * 256 + n] = o; if (n == 254) VCT[((size_t)(b * 4 + g) * 64 + lane) * 256 + 255] = 0; }
        }
    }
    __syncthreads();
}
namespace att {
constexpr int KSTR = 128, TILE_B = 64 * KSTR;
constexpr int NBUF = 4, OFF_K = 0, OFF_V = NBUF * TILE_B, OFF_IMP = 2 * NBUF * TILE_B, OFF_SELM = OFF_IMP + 128 * 65 * 4, OFF_BUN = OFF_SELM + 1024, OFF_Q = OFF_BUN + 64;
constexpr float NEG = -1.0e30f, M0REF = -40.0f;
struct P { unsigned char* ws; f32x4* scr; };

#define MFMA16(a, b, c) __builtin_amdgcn_mfma_f32_16x16x32_bf16((a), (b), (c), 0, 0, 0)

__device__ __forceinline__ void qk_tile3(f32x4 (&st)[3][4], const LAS unsigned char* Kl, const LAS unsigned char* QL, int fr, int fq) {
    bf16x8 kf[4][2];
#pragma unroll
    for (int kt = 0; kt < 4; ++kt)
#pragma unroll
        for (int ks = 0; ks < 2; ++ks) kf[kt][ks] = *(const LAS bf16x8*)(Kl + (16 * kt + fr) * KSTR + (((4 * ks + fq) ^ (fr & 7)) << 4));
#pragma unroll
    for (int r = 0; r < 3; ++r)
#pragma unroll
        for (int kt = 0; kt < 4; ++kt) {
            f32x4 acc = {0.f, 0.f, 0.f, 0.f};
#pragma unroll
            for (int ks = 0; ks < 2; ++ks) acc = MFMA16(kf[kt][ks], *(const LAS bf16x8*)(QL + (r * 2 + ks) * 1024), acc);
            st[r][kt] = acc;
        }
}
__device__ __forceinline__ void qk_tile3_aug(f32x4 (&st)[3][4], const LAS unsigned char* Kl, const LAS unsigned char* QL, const unsigned (&qaw)[3], const unsigned (&kaw)[4], int fr, int fq) {
#pragma unroll
    for (int kt = 0; kt < 4; ++kt) {
        const LAS unsigned char* krow = Kl + (16 * kt + fr) * KSTR;
        const bf16x8 kf0 = *(const LAS bf16x8*)(krow + ((fq ^ (fr & 7)) << 4));
        const bf16x8 kf1 = *(const LAS bf16x8*)(krow + (((4 + fq) ^ (fr & 7)) << 4));
        const u32x4 ka = {kaw[kt], 0u, 0u, 0u};
#pragma unroll
        for (int r = 0; r < 3; ++r) {
            const u32x4 qa = {qaw[r], 0u, 0u, 0u};
            f32x4 acc = MFMA16(__builtin_bit_cast(bf16x8, ka), __builtin_bit_cast(bf16x8, qa), ((f32x4){0.f, 0.f, 0.f, 0.f}));
            acc = MFMA16(kf0, *(const LAS bf16x8*)(QL + (r * 2) * 1024), acc);
            st[r][kt] = MFMA16(kf1, *(const LAS bf16x8*)(QL + (r * 2 + 1) * 1024), acc);
        }
    }
}
__device__ __forceinline__ void pv_tile3(f32x4 (&o)[3][4], const LAS unsigned char* Vl, const f32x4 (&p)[3][4], int fr, int fq) {
    bf16x8 pb[3][2];
#pragma unroll
    for (int r = 0; r < 3; ++r)
#pragma unroll
        for (int kk = 0; kk < 2; ++kk) {
            u32x4 w; w.x = pk2(p[r][2 * kk][0], p[r][2 * kk][1]); w.y = pk2(p[r][2 * kk][2], p[r][2 * kk][3]); w.z = pk2(p[r][2 * kk + 1][0], p[r][2 * kk + 1][1]); w.w = pk2(p[r][2 * kk + 1][2], p[r][2 * kk + 1][3]);
            pb[r][kk] = __builtin_bit_cast(bf16x8, w);
        }
#pragma unroll
    for (int dt = 0; dt < 4; ++dt)
#pragma unroll
        for (int kk = 0; kk < 2; ++kk) {
            const LAS unsigned char* vrow = Vl + (16 * dt + fr) * KSTR + 8 * (fq & 1);
            const u32x2 v0 = *(const LAS u32x2*)(vrow + (((4 * kk + (fq >> 1)) ^ (fr & 7)) << 4)), v1 = *(const LAS u32x2*)(vrow + (((4 * kk + 2 + (fq >> 1)) ^ (fr & 7)) << 4));
            u32x4 w; w.x = v0.x; w.y = v0.y; w.z = v1.x; w.w = v1.y;
            const bf16x8 vf = __builtin_bit_cast(bf16x8, w);
#pragma unroll
            for (int r = 0; r < 3; ++r) o[r][dt] = MFMA16(vf, pb[r][kk], o[r][dt]);
        }
}
__device__ __forceinline__ float ex2(float x) { return __builtin_amdgcn_exp2f(x); }
__device__ __forceinline__ float rmax4(float a) {
    unsigned x = __builtin_bit_cast(unsigned, a);
    auto r1 = __builtin_amdgcn_permlane16_swap(x, x, false, false);
    unsigned u0 = r1[0], u1 = r1[1];
    asm volatile("" : "+v"(u0), "+v"(u1));
    a = fmaxf(__builtin_bit_cast(float, u0), __builtin_bit_cast(float, u1));
    x = __builtin_bit_cast(unsigned, a);
    auto r2 = __builtin_amdgcn_permlane32_swap(x, x, false, false);
    u0 = r2[0]; u1 = r2[1];
    asm volatile("" : "+v"(u0), "+v"(u1));
    return fmaxf(__builtin_bit_cast(float, u0), __builtin_bit_cast(float, u1));
}
__device__ __forceinline__ float max16(const f32x4 (&v)[4]) {
    float a = fmaxf(fmaxf(v[0][0], v[0][1]), fmaxf(v[0][2], v[0][3]));
#pragma unroll
    for (int kt = 1; kt < 4; ++kt) a = fmaxf(a, fmaxf(fmaxf(v[kt][0], v[kt][1]), fmaxf(v[kt][2], v[kt][3])));
    return rmax4(a);
}

__device__ __forceinline__ void qk_half(f32x4 (&st)[3][2], const LAS unsigned char* Kl, const LAS unsigned char* QL, const unsigned (&qaw)[3], const unsigned (&kaw)[4], int hf, const float (&cinit)[3], int fr, int fq) {
    const int sw = fr & 7;
#pragma unroll
    for (int k2 = 0; k2 < 2; ++k2) {
        const LAS unsigned char* krow = Kl + (32 * hf + 16 * k2 + fr) * KSTR;
        const bf16x8 kf0 = *(const LAS bf16x8*)(krow + ((fq ^ sw) << 4));
        const bf16x8 kf1 = *(const LAS bf16x8*)(krow + (((4 + fq) ^ sw) << 4));
        const u32x4 ka = {hf ? kaw[2 + k2] : kaw[k2], 0u, 0u, 0u};
#pragma unroll
        for (int r = 0; r < 3; ++r) {
            const u32x4 qa = {qaw[r], 0u, 0u, 0u};
            f32x4 acc = MFMA16(__builtin_bit_cast(bf16x8, ka), __builtin_bit_cast(bf16x8, qa), ((f32x4){cinit[r], cinit[r], cinit[r], cinit[r]}));
            acc = MFMA16(kf0, *(const LAS bf16x8*)(QL + (r * 2) * 1024), acc);
            st[r][k2] = MFMA16(kf1, *(const LAS bf16x8*)(QL + (r * 2 + 1) * 1024), acc);
        }
    }
}
__device__ __forceinline__ float max8(const f32x4 (&v)[2]) { return fmaxf(fmaxf(fmaxf(v[0][0], v[0][1]), fmaxf(v[0][2], v[0][3])), fmaxf(fmaxf(v[1][0], v[1][1]), fmaxf(v[1][2], v[1][3]))); }
template <int MODE>
__device__ __forceinline__ void flash_step(const LAS unsigned char* Kl, const LAS unsigned char* Vl, const LAS unsigned char* QL, const unsigned (&qaw)[3], const unsigned (&kaw)[4], const float (&sl2)[3],
                                           int rel, int dj, bool sel, bool need_mask, float (&m)[3], f32x4 (&O)[3][5], int fr, int fq) {
    constexpr float THR = 6.0f;
    const float djf = (float)dj;
    const int sw = fr & 7;
    float cmo[3];
#pragma unroll
    for (int r = 0; r < 3; ++r) cmo[r] = sl2[r] * djf - m[r];
#pragma unroll 1
    for (int hf = 0; hf < 2; ++hf) {
        f32x4 st[3][2];
        bf16x8 kfa[2], kfb[2];
#pragma unroll
        for (int k2 = 0; k2 < 2; ++k2) {
            const LAS unsigned char* krow = Kl + (32 * hf + 16 * k2 + fr) * KSTR;
            kfa[k2] = *(const LAS bf16x8*)(krow + ((fq ^ sw) << 4));
            kfb[k2] = *(const LAS bf16x8*)(krow + (((4 + fq) ^ sw) << 4));
        }
        __builtin_amdgcn_s_setprio(1);
#pragma unroll
        for (int r = 0; r < 3; ++r) {
            const u32x4 qa = {qaw[r], 0u, 0u, 0u};
#pragma unroll
            for (int k2 = 0; k2 < 2; ++k2) {
                const u32x4 ka = {hf ? kaw[2 + k2] : kaw[k2], 0u, 0u, 0u};
                f32x4 acc = MFMA16(__builtin_bit_cast(bf16x8, ka), __builtin_bit_cast(bf16x8, qa), ((f32x4){cmo[r], cmo[r], cmo[r], cmo[r]}));
                acc = MFMA16(kfa[k2], *(const LAS bf16x8*)(QL + (r * 2) * 1024), acc);
                st[r][k2] = MFMA16(kfb[k2], *(const LAS bf16x8*)(QL + (r * 2 + 1) * 1024), acc);
            }
        }
        __builtin_amdgcn_s_setprio(0);
        if (need_mask) {
#pragma unroll
            for (int k2 = 0; k2 < 2; ++k2)
#pragma unroll
                for (int e = 0; e < 4; ++e) {
                    const int pr = rel + 32 * hf + 16 * k2 + e;
                    bool ok = pr <= 0;
                    if (MODE == 0) ok = ok && sel; else ok = ok && (pr > -512);
#pragma unroll
                    for (int r = 0; r < 3; ++r) st[r][k2][e] = ok ? st[r][k2][e] : NEG;
                }
        }
        float a[3];
#pragma unroll
        for (int r = 0; r < 3; ++r) a[r] = fmaxf(fmaxf(fmaxf(st[r][0][0], st[r][0][1]), fmaxf(st[r][0][2], st[r][0][3])), fmaxf(fmaxf(st[r][1][0], st[r][1][1]), fmaxf(st[r][1][2], st[r][1][3])));
        if (__any(fmaxf(fmaxf(a[0], a[1]), a[2]) > THR)) {
#pragma unroll
            for (int r = 0; r < 3; ++r) {
                const float mx = rmax4(a[r]);
                const float delta = mx > THR ? mx : 0.f;
                m[r] += delta; cmo[r] -= delta;
                const float alpha = ex2(-delta);
#pragma unroll
                for (int dt = 0; dt < 5; ++dt) O[r][dt] = O[r][dt] * alpha;
#pragma unroll
                for (int k2 = 0; k2 < 2; ++k2) st[r][k2] = st[r][k2] - delta;
            }
        }
        bf16x8 vf[4];
#pragma unroll
        for (int dt = 0; dt < 4; ++dt) {
            const LAS unsigned char* vrow = Vl + (16 * dt + fr) * KSTR + 8 * (fq & 1);
            const u32x2 v0 = *(const LAS u32x2*)(vrow + (((4 * hf + (fq >> 1)) ^ sw) << 4)), v1 = *(const LAS u32x2*)(vrow + (((4 * hf + 2 + (fq >> 1)) ^ sw) << 4));
            u32x4 w; w.x = v0.x; w.y = v0.y; w.z = v1.x; w.w = v1.y;
            vf[dt] = __builtin_bit_cast(bf16x8, w);
        }
        const unsigned one2 = (fr == 0) ? 0x3f803f80u : 0u;
        const u32x4 w1 = {one2, one2, one2, one2};
        const bf16x8 vone = __builtin_bit_cast(bf16x8, w1);
#pragma unroll
        for (int r = 0; r < 3; ++r) {
#pragma unroll
            for (int k2 = 0; k2 < 2; ++k2)
#pragma unroll
                for (int e = 0; e < 4; ++e) st[r][k2][e] = ex2(st[r][k2][e]);
            u32x4 w; w.x = pk2(st[r][0][0], st[r][0][1]); w.y = pk2(st[r][0][2], st[r][0][3]); w.z = pk2(st[r][1][0], st[r][1][1]); w.w = pk2(st[r][1][2], st[r][1][3]);
            const bf16x8 pb = __builtin_bit_cast(bf16x8, w);
            __builtin_amdgcn_s_setprio(1);
#pragma unroll
            for (int dt = 0; dt < 4; ++dt) O[r][dt] = MFMA16(vf[dt], pb, O[r][dt]);
            O[r][4] = MFMA16(vone, pb, O[r][4]);
            __builtin_amdgcn_s_setprio(0);
        }
    }
}

#define ATT_DMA(buf, kp, vp, vstride) do { \
    __builtin_amdgcn_global_load_lds((const unsigned*)((kp) + lrow * 64 + lchs * 8), (LAS unsigned*)(lds + OFF_K + (buf) * TILE_B + w * 1024), 16, 0, 0); \
    __builtin_amdgcn_global_load_lds((const unsigned*)((vp) + (size_t)lrow * (vstride) + lchs * 8), (LAS unsigned*)(lds + OFF_V + (buf) * TILE_B + w * 1024), 16, 0, 0); } while (0)
#define ATT_WAIT_SYNC() do { asm volatile("s_waitcnt vmcnt(0) lgkmcnt(0)\n\ts_barrier" ::: "memory"); } while (0)
#define ATT_WAIT_SYNC2(more) do { if (more) asm volatile("s_waitcnt vmcnt(2) lgkmcnt(0)\n\ts_barrier" ::: "memory"); else asm volatile("s_waitcnt vmcnt(0) lgkmcnt(0)\n\ts_barrier" ::: "memory"); } while (0)
#define ATT_POP(rem_, j_) do { j_ = 63 - __builtin_clzll(rem_); rem_ &= ~(1ull << j_); } while (0)

#define ATT_QDMA(bb, gg, II) do { const bf16* q_ = (const bf16*)(p.ws + WS_Q) + ((size_t)(bb) * T + 128 * (II) + 16 * w + fr) * 768 + 3 * (gg) * 64 + 8 * fq; \
    _Pragma("unroll") for (int r_ = 0; r_ < 3; ++r_) _Pragma("unroll") for (int ks_ = 0; ks_ < 2; ++ks_) \
        __builtin_amdgcn_global_load_lds((const unsigned*)(q_ + r_ * 64 + 32 * ks_), (LAS unsigned*)(lds + OFF_Q + w * 6144 + (r_ * 2 + ks_) * 1024), 16, 0, 0); } while (0)
__device__ __forceinline__ void attn_item(LAS unsigned char* lds, const P& p, int b, int g, int I, bool first, int nbg, int nI) {
    const int tid = my_tid(), lane = tid & 63, w = __builtin_amdgcn_readfirstlane(tid >> 6), fr = lane & 15, fq = lane >> 4;
    const int tq = 128 * I + 16 * w + fr;
    const int iq = 2 * I + (w >> 2);
    const size_t row = (size_t)b * T + tq;
    const int bg = b * 4 + g;
    const int lrow = tid >> 3, lchs = (tid & 7) ^ (lrow & 7);
    LAS float* IMP = (LAS float*)(lds + OFF_IMP);
    LAS unsigned* SELM = (LAS unsigned*)(lds + OFF_SELM);
    LAS unsigned* BUN = (LAS unsigned*)(lds + OFF_BUN);
    for (int i = tid; i < 128 * 65; i += 512) IMP[i] = 0.f;
    if (tid < 2) BUN[tid] = 0u;
    LAS unsigned char* QL = lds + OFF_Q + w * 6144 + lane * 16;
    if (first) ATT_QDMA(b, g, I);
    float sl2[3];
#pragma unroll
    for (int r = 0; r < 3; ++r) {
        const int h = 3 * g + r;
        sl2[r] = (h < 8 ? exp2f(-(float)(h + 1)) : exp2f(-(0.5f + (float)(h - 8)))) * LOG2E;
    }
    LAS float* gp = (LAS float*)(lds + OFF_Q + 49152) + (16 * w + fr) * 12;
    if (fq < 3) { const float* gsrc = (const float*)(p.ws + WS_G) + row * 36 + 9 * g + 3 * fq; const float g0 = gsrc[0], g1 = gsrc[1], g2 = gsrc[2]; gp[3 * fq] = g0; gp[3 * fq + 1] = g1; gp[3 * fq + 2] = g2; }
    unsigned qaw[3], kaw[4];
#pragma unroll
    for (int r = 0; r < 3; ++r) { const unsigned hi = f2bf(sl2[r]); const unsigned lo = f2bf(sl2[r] - __builtin_bit_cast(float, hi << 16)); qaw[r] = (fq == 0) ? (hi | (lo << 16)) : 0u; }
#pragma unroll
    for (int kt = 0; kt < 4; ++kt) { const unsigned c = f2bf((float)(16 * kt + fr)); kaw[kt] = (fq == 0) ? (c | (c << 16)) : 0u; }
    unsigned qaw16[3];
#pragma unroll
    for (int r = 0; r < 3; ++r) { const float x = 16.0f * sl2[r]; const unsigned hi = f2bf(x); const unsigned lo = f2bf(x - __builtin_bit_cast(float, hi << 16)); qaw16[r] = (fq == 0) ? (hi | (lo << 16)) : 0u; }
    const int tqmin = 128 * I + 16 * w;
    const bf16* KCp = (const bf16*)(p.ws + WS_KC) + (size_t)bg * 256 * 64; const bf16* VCp = (const bf16*)(p.ws + WS_VCT) + (size_t)bg * 64 * 256;
    const int nT = (8 * I + 7 + 63) >> 6;
    const int tqmax = 128 * I + 16 * w + 15;
    float m[3], l[3];
#pragma unroll
    for (int r = 0; r < 3; ++r) { m[r] = M0REF; l[r] = 0.f; }
    for (int t = 0; t < nT; ++t) ATT_DMA(t, KCp + t * 64 * 64, VCp + t * 64, 256);
    ATT_WAIT_SYNC();
    for (int Tt = 0; Tt < nT; ++Tt) {
        if (1024 * Tt + 31 <= tqmax) {
            const LAS unsigned char* Kl = lds + OFF_K + Tt * TILE_B;
            const int crel = 16 * (64 * Tt + 4 * fq) - tq;
            const bool full = 16 * (64 * Tt + 63) + 31 <= tqmin;
            const float cb = (float)(1024 * Tt - tq) + 15.5f;
            float cmo[3];
#pragma unroll
            for (int r = 0; r < 3; ++r) cmo[r] = sl2[r] * cb - m[r];
#pragma unroll 1
            for (int hf = 0; hf < 2; ++hf) {
                f32x4 st[3][2]; qk_half(st, Kl, QL, qaw16, kaw, hf, cmo, fr, fq);
                if (!full) {
#pragma unroll
                    for (int k2 = 0; k2 < 2; ++k2)
#pragma unroll
                        for (int e = 0; e < 4; ++e) { const bool ok = crel + 512 * hf + 256 * k2 + 16 * e + 31 <= 0;
#pragma unroll
                            for (int r = 0; r < 3; ++r) st[r][k2][e] = ok ? st[r][k2][e] : NEG; }
                }
                float a[3];
#pragma unroll
                for (int r = 0; r < 3; ++r) a[r] = max8(st[r]);
                if (__any(fmaxf(fmaxf(a[0], a[1]), a[2]) > 6.0f)) {
#pragma unroll
                    for (int r = 0; r < 3; ++r) {
                        const float mx = rmax4(a[r]);
                        const float delta = mx > 6.0f ? mx : 0.f;
                        m[r] += delta; cmo[r] -= delta; l[r] *= ex2(-delta);
#pragma unroll
                        for (int k2 = 0; k2 < 2; ++k2) st[r][k2] = st[r][k2] - delta;
                    }
                }
#pragma unroll
                for (int r = 0; r < 3; ++r) {
                    float ps = 0.f;
#pragma unroll
                    for (int k2 = 0; k2 < 2; ++k2)
#pragma unroll
                        for (int e = 0; e < 4; ++e) ps += ex2(st[r][k2][e]);
                    l[r] += ps;
                }
            }
        }
    }
    float invl[3];
#pragma unroll
    for (int r = 0; r < 3; ++r) { float s = l[r]; s += __shfl_xor(s, 16); s += __shfl_xor(s, 32); invl[r] = s > 0.f ? -(m[r] + __builtin_amdgcn_logf(s)) : NEG; }
    __syncthreads();
    f32x4 O[3][4];
#pragma unroll
    for (int r = 0; r < 3; ++r)
#pragma unroll
        for (int dt = 0; dt < 4; ++dt) O[r][dt] = (f32x4){0.f, 0.f, 0.f, 0.f};
    for (int Tt = 0; Tt < nT; ++Tt) {
        if (1024 * Tt + 31 <= tqmax) {
            const LAS unsigned char* Kl = lds + OFF_K + Tt * TILE_B; const LAS unsigned char* Vl = lds + OFF_V + Tt * TILE_B;
            const int crel = 16 * (64 * Tt + 4 * fq) - tq;
            const bool full = 16 * (64 * Tt + 63) + 31 <= tqmin;
            const float cb = (float)(1024 * Tt - tq) + 15.5f;
            const int sw = fr & 7;
            float cfin[3];
#pragma unroll
            for (int r = 0; r < 3; ++r) cfin[r] = sl2[r] * cb + invl[r];
#pragma unroll 1
            for (int hf = 0; hf < 2; ++hf) {
                f32x4 st[3][2]; qk_half(st, Kl, QL, qaw16, kaw, hf, cfin, fr, fq);
                float ia[2] = {0.f, 0.f}, ib[2] = {0.f, 0.f};
                bf16x8 vf[4];
#pragma unroll
                for (int dt = 0; dt < 4; ++dt) {
                    const LAS unsigned char* vrow = Vl + (16 * dt + fr) * KSTR + 8 * (fq & 1);
                    const u32x2 v0 = *(const LAS u32x2*)(vrow + (((4 * hf + (fq >> 1)) ^ sw) << 4)), v1 = *(const LAS u32x2*)(vrow + (((4 * hf + 2 + (fq >> 1)) ^ sw) << 4));
                    u32x4 w; w.x = v0.x; w.y = v0.y; w.z = v1.x; w.w = v1.y;
                    vf[dt] = __builtin_bit_cast(bf16x8, w);
                }
#pragma unroll
                for (int r = 0; r < 3; ++r) {
#pragma unroll
                    for (int k2 = 0; k2 < 2; ++k2) {
                        if (full) {
#pragma unroll
                            for (int e = 0; e < 4; ++e) st[r][k2][e] = ex2(st[r][k2][e]);
                        } else {
#pragma unroll
                            for (int e = 0; e < 4; ++e) st[r][k2][e] = (crel + 512 * hf + 256 * k2 + 16 * e + 31 <= 0) ? ex2(st[r][k2][e]) : 0.f;
                        }
                        ia[k2] += (st[r][k2][0] + st[r][k2][1]) + (st[r][k2][2] + st[r][k2][3]); ib[k2] += st[r][k2][3];
                    }
                    u32x4 w; w.x = pk2(st[r][0][0], st[r][0][1]); w.y = pk2(st[r][0][2], st[r][0][3]); w.z = pk2(st[r][1][0], st[r][1][1]); w.w = pk2(st[r][1][2], st[r][1][3]);
                    const bf16x8 pb = __builtin_bit_cast(bf16x8, w);
#pragma unroll
                    for (int dt = 0; dt < 4; ++dt) O[r][dt] = MFMA16(vf[dt], pb, O[r][dt]);
                }
                LAS float* ip = IMP + (16 * w + fr) * 65 + 16 * Tt + 8 * hf + fq;
#pragma unroll
                for (int k2 = 0; k2 < 2; ++k2) {
                    __hip_atomic_fetch_add(ip + 4 * k2, ia[k2], __ATOMIC_RELAXED, __HIP_MEMORY_SCOPE_WORKGROUP);
                    if (16 * Tt + 8 * hf + 4 * k2 + fq + 1 < 64) __hip_atomic_fetch_add(ip + 4 * k2 + 1, ib[k2], __ATOMIC_RELAXED, __HIP_MEMORY_SCOPE_WORKGROUP);
                }
            }
        }
    }
#pragma unroll
    for (int r = 0; r < 3; ++r) { const float gc = gp[3 * r + 0];
#pragma unroll
        for (int dt = 0; dt < 4; ++dt) p.scr[(r * 4 + dt) * 512] = O[r][dt] * gc; }
    __syncthreads();
    {
        const int tok = tid >> 2, qd = tid & 3, cur = iq;
        unsigned long long mask;
        if (cur < 8) mask = (2ull << cur) - 1ull;
        else {
            mask = 1ull | (1ull << cur) | (1ull << (cur - 1));
            float v[16];
#pragma unroll
            for (int jj = 0; jj < 16; ++jj) { const int j = 16 * qd + jj; const float x = IMP[tok * 65 + j]; v[jj] = (j <= cur && j != 0 && j != cur && j != cur - 1) ? x : -1.0f; }
#pragma unroll 1
            for (int rd = 0; rd < 5; ++rd) {
                float bv = v[0]; int bj = 16 * qd;
#pragma unroll
                for (int jj = 1; jj < 16; ++jj) if (v[jj] > bv) { bv = v[jj]; bj = 16 * qd + jj; }
#pragma unroll
                for (int o = 1; o <= 2; o <<= 1) {
                    const int bvb = __builtin_bit_cast(int, bv);
                    const float ov = __builtin_bit_cast(float, o == 1 ? __builtin_amdgcn_update_dpp(bvb, bvb, 0xB1, 0xF, 0xF, true) : __builtin_amdgcn_update_dpp(bvb, bvb, 0x4E, 0xF, 0xF, true));
                    const int oj = o == 1 ? __builtin_amdgcn_update_dpp(bj, bj, 0xB1, 0xF, 0xF, true) : __builtin_amdgcn_update_dpp(bj, bj, 0x4E, 0xF, 0xF, true);
                    if (ov > bv || (ov == bv && oj < bj)) { bv = ov; bj = oj; } }
                if (bv >= 0.f) mask |= 1ull << bj;
#pragma unroll
                for (int jj = 0; jj < 16; ++jj) if (16 * qd + jj == bj) v[jj] = -1.0f;
            }
        }
        if (qd == 0) { SELM[tok * 2] = (unsigned)mask; SELM[tok * 2 + 1] = (unsigned)(mask >> 32); }
    }
    __syncthreads();
    const unsigned selLo = SELM[(16 * w + fr) * 2], selHi = SELM[(16 * w + fr) * 2 + 1];
    unsigned wlo = selLo, whi = selHi;
#pragma unroll
    for (int o = 1; o <= 8; o <<= 1) { wlo |= __shfl_xor(wlo, o); whi |= __shfl_xor(whi, o); }
    wlo = __builtin_amdgcn_readfirstlane(wlo); whi = __builtin_amdgcn_readfirstlane(whi);
    if (lane == 0) { __hip_atomic_fetch_or(BUN, wlo, __ATOMIC_RELAXED, __HIP_MEMORY_SCOPE_WORKGROUP); __hip_atomic_fetch_or(BUN + 1, whi, __ATOMIC_RELAXED, __HIP_MEMORY_SCOPE_WORKGROUP); }
    __syncthreads();
    const unsigned long long bun = (unsigned long long)__builtin_amdgcn_readfirstlane(BUN[0]) | ((unsigned long long)__builtin_amdgcn_readfirstlane(BUN[1]) << 32);
    const unsigned long long wun = (unsigned long long)wlo | ((unsigned long long)whi << 32);
    const unsigned long long selm = (unsigned long long)selLo | ((unsigned long long)selHi << 32);
    f32x4 O5[3][5];
    {
        const bf16* Kp = (const bf16*)(p.ws + WS_KS) + (size_t)bg * T * 64; const bf16* Vp = (const bf16*)(p.ws + WS_VST) + (size_t)bg * 64 * T;
#pragma unroll
        for (int r = 0; r < 3; ++r) { m[r] = M0REF;
#pragma unroll
            for (int dt = 0; dt < 5; ++dt) O5[r][dt] = (f32x4){0.f, 0.f, 0.f, 0.f}; }
        unsigned long long rem = bun; int cur = 0, ja, jb = -1;
        asm volatile("s_waitcnt vmcnt(0)" ::: "memory");
        ATT_POP(rem, ja); ATT_DMA(0, Kp + (size_t)ja * 64 * 64, Vp + ja * 64, T);
        if (rem) { ATT_POP(rem, jb); ATT_DMA(1, Kp + (size_t)jb * 64 * 64, Vp + jb * 64, T); }
        while (ja >= 0) {
            ATT_WAIT_SYNC();
            int na = -1, nb = -1;
            if (rem) { ATT_POP(rem, na); ATT_DMA(cur ^ 2, Kp + (size_t)na * 64 * 64, Vp + na * 64, T); }
            if (rem) { ATT_POP(rem, nb); ATT_DMA((cur ^ 2) + 1, Kp + (size_t)nb * 64 * 64, Vp + nb * 64, T); }
            if ((wun >> ja) & 1ull) {
                const bool selb = ((selm >> ja) & 1ull) != 0ull;
                const bool nm = (ja == iq) || !__all(selb);
                flash_step<0>(lds + OFF_K + cur * TILE_B, lds + OFF_V + cur * TILE_B, QL, qaw, kaw, sl2, 64 * ja + 4 * fq - tq, 64 * ja - tq, selb, nm, m, O5, fr, fq);
            }
            if (jb >= 0 && ((wun >> jb) & 1ull)) {
                const bool selb = ((selm >> jb) & 1ull) != 0ull;
                const bool nm = (jb == iq) || !__all(selb);
                flash_step<0>(lds + OFF_K + (cur + 1) * TILE_B, lds + OFF_V + (cur + 1) * TILE_B, QL, qaw, kaw, sl2, 64 * jb + 4 * fq - tq, 64 * jb - tq, selb, nm, m, O5, fr, fq);
            }
            ja = na; jb = nb; cur ^= 2;
        }
#pragma unroll
        for (int r = 0; r < 3; ++r) { const float s = __shfl(O5[r][4][0], fr); const float sc = gp[3 * r + 1] / s;
#pragma unroll
            for (int dt = 0; dt < 4; ++dt) p.scr[(12 + r * 4 + dt) * 512] = O5[r][dt] * sc; }
    }
    __syncthreads();
    {
        const bf16* Kp = (const bf16*)(p.ws + WS_KW) + (size_t)bg * T * 64; const bf16* Vp = (const bf16*)(p.ws + WS_VWT) + (size_t)bg * 64 * T;
#pragma unroll
        for (int r = 0; r < 3; ++r) { m[r] = M0REF;
#pragma unroll
            for (int dt = 0; dt < 5; ++dt) O5[r][dt] = (f32x4){0.f, 0.f, 0.f, 0.f}; }
        const int jlo = (2 * I - 8) > 0 ? (2 * I - 8) : 0, jhi = 2 * I + 1;
        asm volatile("s_waitcnt vmcnt(0)" ::: "memory");
        ATT_DMA(0, Kp + (size_t)jhi * 64 * 64, Vp + jhi * 64, T);
        if (jhi - 1 >= jlo) ATT_DMA(1, Kp + (size_t)(jhi - 1) * 64 * 64, Vp + (jhi - 1) * 64, T);
        int cur = 0;
        for (int j = jhi; j >= jlo; j -= 2) {
            ATT_WAIT_SYNC();
            if (j - 2 >= jlo) ATT_DMA(cur ^ 2, Kp + (size_t)(j - 2) * 64 * 64, Vp + (j - 2) * 64, T);
            if (j - 3 >= jlo) ATT_DMA((cur ^ 2) + 1, Kp + (size_t)(j - 3) * 64 * 64, Vp + (j - 3) * 64, T);
            if (j >= iq - 8 && j <= iq)
                flash_step<1>(lds + OFF_K + cur * TILE_B, lds + OFF_V + cur * TILE_B, QL, qaw, kaw, sl2, 64 * j + 4 * fq - tq, 64 * j - tq, true, (j == iq) || (j == iq - 8), m, O5, fr, fq);
            const int jj = j - 1;
            if (jj >= jlo && jj >= iq - 8 && jj <= iq)
                flash_step<1>(lds + OFF_K + (cur + 1) * TILE_B, lds + OFF_V + (cur + 1) * TILE_B, QL, qaw, kaw, sl2, 64 * jj + 4 * fq - tq, 64 * jj - tq, true, (jj == iq) || (jj == iq - 8), m, O5, fr, fq);
            cur ^= 2;
        }
        if (nI >= 0) ATT_QDMA(nbg >> 2, nbg & 3, nI);
#pragma unroll
        for (int r = 0; r < 3; ++r) { const float s = __shfl(O5[r][4][0], fr); const float sc = gp[3 * r + 2] / s;
#pragma unroll
            for (int dt = 0; dt < 4; ++dt) {
                const f32x4 v = (p.scr[(r * 4 + dt) * 512] + p.scr[(12 + r * 4 + dt) * 512]) + O5[r][dt] * sc;
                *(unsigned long long*)((bf16*)(p.ws + WS_XN) + row * D + 256 + (3 * g + r) * 64 + 16 * dt + 4 * fq) = (unsigned long long)pk2(v[0], v[1]) | ((unsigned long long)pk2(v[2], v[3]) << 32);
            } }
    }
    __syncthreads();
}

__device__ __forceinline__ void attn_decode(int L, int G, int& bg, int& I) {
    if (G == 256) {
        const int v = L & 255, i = L >> 8, c = v >> 3, s = c & 7, q = c >> 3, ii = (i + q) & 3;
        bg = (v & 7) * 4 + i; I = (ii == 0) ? s : (ii == 1) ? 15 - s : (ii == 2) ? 16 + s : 31 - s; }
    else { bg = L >> 5; I = L & 31; }
}
__device__ __forceinline__ void attn_phase(LAS unsigned char* lds, const P& p, int blk, int G) {
    bool first = true;
    for (int L = blk; L < 1024; L += G) {
        int bg, I, nbg = 0, nI = -1;
        attn_decode(L, G, bg, I);
        if (L + G < 1024) attn_decode(L + G, G, nbg, nI);
        attn_item(lds, p, bg >> 2, bg & 3, I, first, nbg, nI);
        first = false;
    }
}
}
#define XB_TMO      128
#define XB_XCNT(j)  (256  + 64 * (j))
#define XB_XSUB(j)  (1280 + 64 * (j))
#define XB_XGEN(j)  (2304 + 64 * (j))
#define XB_TOP      3328
#define XB_TOPGEN   3392
#define XCD_BAR_WORDS 3456
#define XB_SPIN_CAP (1u << 18)

__device__ __forceinline__ unsigned xb_ld(unsigned* p)              { return __hip_atomic_load(p, __ATOMIC_RELAXED, __HIP_MEMORY_SCOPE_AGENT); }
__device__ __forceinline__ unsigned xb_add(unsigned* p, unsigned v) { return __hip_atomic_fetch_add(p, v, __ATOMIC_RELAXED, __HIP_MEMORY_SCOPE_AGENT); }
__device__ __forceinline__ unsigned xb_xcc_id() { return (unsigned)__builtin_amdgcn_s_getreg((3 << 11) | 20) & 0xFu; }
#define XB_SPIN(cond, bar) do { unsigned _sp = 0; while (cond) { __builtin_amdgcn_s_sleep(1); \
    if ((++_sp & 255u) == 0u) { if (xb_ld(&(bar)[XB_TMO])) break; if (_sp > XB_SPIN_CAP) { atomicAdd(&(bar)[XB_TMO], 1u); break; } } } } while (0)

struct XcdBarrier {
    unsigned* bar; unsigned x;
    volatile LAS unsigned* st;
};

__device__ __forceinline__ XcdBarrier xcd_barrier_post(unsigned* bar, volatile LAS unsigned* st) {
    XcdBarrier b; b.bar = bar; b.x = xb_xcc_id(); b.st = st;
    if (threadIdx.x == 0) (void)xb_add(&bar[XB_XCNT(b.x)], 1u);
    return b;
}
__device__ __forceinline__ void xcd_barrier_complete(unsigned* bar, unsigned x, unsigned& nloc, unsigned& nx) {
    const unsigned G = gridDim.x * gridDim.y * gridDim.z;
    unsigned sum, cnt, mine, sp = 0u;
    for (;;) {
        sum = 0u; cnt = 0u; mine = 0u;
#pragma unroll
        for (unsigned j = 0; j < 16; ++j) { const unsigned c = xb_ld(&bar[XB_XCNT(j)]); sum += c; cnt += (c > 0u) ? 1u : 0u; mine = (j == x) ? c : mine; }
        if (sum == G) break;
        __builtin_amdgcn_s_sleep(1);
        if ((++sp & 255u) == 0u) { if (xb_ld(&bar[XB_TMO])) break; if (sp > XB_SPIN_CAP) { atomicAdd(&bar[XB_TMO], 1u); break; } }
    }
    nloc = mine > 0u ? mine : 1u; nx = cnt > 0u ? cnt : 1u;
}

__device__ __forceinline__ void xcd_barrier(const XcdBarrier& b) {
    asm volatile("s_waitcnt vmcnt(0)" ::: "memory");
    __syncthreads();
    if (threadIdx.x == 0) {
        unsigned* bar = b.bar;
        __builtin_amdgcn_s_waitcnt(0);
        unsigned nloc = b.st[0], nx = b.st[1];
        if (nloc == 0u) { xcd_barrier_complete(bar, b.x, nloc, nx); b.st[0] = nloc; b.st[1] = nx; }
        const unsigned old = xb_add(&bar[XB_XSUB(b.x)], 1u);
        const unsigned gen = old / nloc;
        if (old + 1u == (gen + 1u) * nloc) {
            __builtin_amdgcn_fence(__ATOMIC_RELEASE, "agent");
            asm volatile("s_waitcnt vmcnt(0)" ::: "memory");
            const unsigned og = xb_add(&bar[XB_TOP], 1u);
            const unsigned tg = og / nx;
            if (og + 1u == (tg + 1u) * nx) xb_add(&bar[XB_TOPGEN], 1u);
            else XB_SPIN(xb_ld(&bar[XB_TOPGEN]) == tg, bar);
            __builtin_amdgcn_fence(__ATOMIC_ACQUIRE, "agent");
            xb_add(&bar[XB_XGEN(b.x)], 1u);
            asm volatile("s_waitcnt vmcnt(0)" ::: "memory");
        } else {
            XB_SPIN(xb_ld(&bar[XB_XGEN(b.x)]) == gen, bar);
            __builtin_amdgcn_fence(__ATOMIC_ACQUIRE, "agent");
            asm volatile("s_waitcnt vmcnt(0)" ::: "memory");
        }
    }
    __syncthreads();
}

__global__ void __launch_bounds__(512, 2) hymba_fwd(Args args) {
    extern __shared__ __attribute__((aligned(16))) unsigned char lds_raw[];
    LAS unsigned char* lds = (LAS unsigned char*)lds_raw;
    cg::grid_group grid = cg::this_grid();
    const int G = gridDim.x;
    {
        LAS unsigned long long* ptw = (LAS unsigned long long*)(lds + MISC_OFF + 64);
        if (threadIdx.x == 0) {
#pragma unroll
            for (int i = 0; i < 18; ++i) ptw[i] = (unsigned long long)args.in[i];
            ptw[18] = (unsigned long long)args.out; ptw[19] = (unsigned long long)args.ws;
        }
    }
    const int ph_lo = args.ph_lo, ph_hi = args.ph_hi;
    if (threadIdx.x < 8) ((LAS unsigned*)(lds + MISC_OFF))[threadIdx.x] = 0u;
    __syncthreads();
    XcdBarrier xbar = xcd_barrier_post((unsigned*)(args.ws + WS_CTL), (volatile LAS unsigned*)(lds + MISC_OFF));
    bool first_sync = (ph_lo < 0);
#ifndef USE_CG_SYNC
#define USE_CG_SYNC 0
#endif
#ifndef PROBE_DUP_MASK
#define PROBE_DUP_MASK 0
#endif
#ifndef PROBE_DUP_SYNC
#define PROBE_DUP_SYNC 0
#endif
    for (int ph2 = ph_lo * 2; ph2 < ph_hi * 2; ++ph2) {
        const int ph = ph2 >> 1;
        const int layer = ph / NPH, k = ph % NPH;
        if ((ph2 & 1) && !((PROBE_DUP_MASK >> k & 1) && ph != DEPTH * NPH)) continue;
        int blk = blockIdx.x; asm volatile("" : "+s"(blk));
        PT a; a.t = (LAS const unsigned long long*)(lds + MISC_OFF + 64); a.ap = &args; a.ws = (unsigned char*)a.raw(19);
        unsigned char* ws = a.ws; float* X = (float*)(ws + WS_X); bf16* XN = (bf16*)(ws + WS_XN);
        const float* xin = layer == 0 ? a.in(0) : X;
        unsigned char* wset = ws + WS_WSET + (size_t)(layer & 1) * WSET_BYTES;
        bf16* XB = (bf16*)(ws + WS_XB); float* RSQ1 = (float*)(ws + WS_RSQ); float* RSQ2 = RSQ1 + (size_t)M * 16;
        if (ph != DEPTH * NPH && ((k == 0 && layer > 0) || k == 8)) continue;
        if (ph == DEPTH * NPH) {
            final_rows(XB, RSQ1, a.in(17), (float*)a.raw(18), blk, G);
        } else if (k == 0) {
            prologue_layer(a, 0, lds, blk, G);
            first_rows(xin, XB, RSQ1, blk, G);
        } else if (k == 1) {
            pg8::Gemm g{XB, (const bf16*)(wset + OFF_WIN), M, 2560, D}; pg8::StaticOrder S; S.init(M, 2560, G, blk);
            LAS float* RS = (LAS float*)(lds + 131072); pg8::prep_rstd(S, RSQ1, RS, my_tid());
            pg8::EpiWin E{(bf16*)(ws + WS_ACONV), (bf16*)(ws + WS_Q), (bf16*)(ws + WS_KCR), (bf16*)(ws + WS_VCR), (bf16*)(ws + WS_KS), (bf16*)(ws + WS_KW), (float*)(ws + WS_G), RS};
            pg8::gemm_phase<pg8::EpiWin, pg8::StaticOrder, true, true, false>(lds, g, S, E);
        } else if (k == 2) {
            pg8::Gemm g{XB, (const bf16*)(wset + OFF_WIN) + (size_t)2560 * D, M, 512, D}; pg8::StaticOrder S; S.init(M, 512, G, blk);
            LAS float* RS = (LAS float*)(lds + 131072); pg8::prep_rstd(S, RSQ1, RS, my_tid());
            pg8::EpiVT E{(bf16*)(ws + WS_VST), (bf16*)(ws + WS_VWT), RS};
            pg8::gemm_phase<pg8::EpiVT, pg8::StaticOrder, true, true, true>(lds, g, S, E);
        } else if (k == 3) {
            pg8::Gemm g{(const bf16*)(ws + WS_KCR), (const bf16*)(wset + OFF_CMPW), 16384, 1024, D}; pg8::CmpOrder S{G, blk};
            pg8::EpiCmp E{(float*)(ws + WS_LOHI)};
            pg8::gemm_phase<pg8::EpiCmp, pg8::CmpOrder, true, true, false>(lds, g, S, E);
        } else if (k == 4) {
            conv_phase(a, layer, lds, blk, G);
        } else if (k == 5) {
            cmp2_phase(a, layer, lds, blk, G);
            if (layer + 1 < DEPTH) { __syncthreads(); prologue_layer(a, layer + 1, lds, blk, G); }
        } else if (k == 6) {
            att::P p{ws, (f32x4*)(ws + WS_ASCR) + (size_t)blk * (24 * 512) + my_tid()};
            att::attn_phase(lds, p, blk, G);
        } else if (k == 7) {
            pg8::Gemm g{XN, (const bf16*)(wset + OFF_WOUT), M, D, D}; pg8::StaticOrder S; S.init(M, D, G, blk);
            pg8::EpiRes E{XB, RSQ2};
            pg8::gemm_phase<pg8::EpiRes, pg8::StaticOrder, true, true, false>(lds, g, S, E);
        } else if (k == 9) {
            pg8::Gemm g{XB, (const bf16*)(wset + OFF_WGU), M, 2 * DFF, D}; pg8::StaticOrder S; S.init(M, 2 * DFF, G, blk);
            LAS float* RS = (LAS float*)(lds + 131072); pg8::prep_rstd(S, RSQ2, RS, my_tid());
            pg8::EpiSwiglu E{(bf16*)(ws + WS_HFF), RS};
            pg8::gemm_phase<pg8::EpiSwiglu, pg8::StaticOrder, true, true, false>(lds, g, S, E);
        } else {
            pg8::Gemm g{(const bf16*)(ws + WS_HFF), (const bf16*)(wset + OFF_WD), M, D, DFF}; pg8::StaticOrder S; S.init(M, D, G, blk);
            pg8::EpiRes E{XB, RSQ1};
            pg8::gemm_phase<pg8::EpiRes, pg8::StaticOrder, true, true, false>(lds, g, S, E);
        }
        if (ph2 + 1 < ph_hi * 2) { if ((k == 1 || k == 3) && !(PROBE_DUP_MASK >> k & 1)) __syncthreads(); else { if (first_sync || USE_CG_SYNC) { grid.sync(); first_sync = false; } else xcd_barrier(xbar); if (PROBE_DUP_SYNC) xcd_barrier(xbar); } }
    }
}

#ifndef MULTI_LAUNCH
#define MULTI_LAUNCH 0
#endif
extern "C" void kernel_launch(void* const* d_in, const int* in_sizes, int n_in, void* d_out, int out_size, void* d_ws, size_t ws_size, hipStream_t stream) {
    static int grid = 0;
    if (grid == 0) {
        if (n_in != 18 || out_size != M * D || ws_size < WS_END) { fprintf(stderr, "kernel_launch: unexpected shapes: n_in %d out %d ws %zu (need %zu)\n", n_in, out_size, ws_size, (size_t)WS_END); grid = -1; return; }
        int dev = 0, cus = 0, per_cu = 0;
        (void)hipGetDevice(&dev);
        (void)hipDeviceGetAttribute(&cus, hipDeviceAttributeMultiprocessorCount, dev);
        (void)hipFuncSetAttribute((const void*)hymba_fwd, hipFuncAttributeMaxDynamicSharedMemorySize, LDS_BYTES);
        (void)hipOccupancyMaxActiveBlocksPerMultiprocessor(&per_cu, (const void*)hymba_fwd, 512, LDS_BYTES);
        fprintf(stderr, "kernel_launch: cus %d per_cu %d ws %zu\n", cus, per_cu, ws_size);
        if (per_cu < 1) { fprintf(stderr, "kernel_launch: occupancy query says 0 blocks per CU\n"); per_cu = 1; }
        grid = cus;
        (void)hipGetLastError();
    }
    if (grid < 0) return;
    (void)hipMemsetAsync((char*)d_ws + WS_CTL, 0, CTL_ZERO_BYTES, stream);
    Args a{};
    for (int i = 0; i < 18; ++i) a.in[i] = (const float*)d_in[i];
    a.out = (float*)d_out; a.ws = (unsigned char*)d_ws;
#if MULTI_LAUNCH
    for (int ph = 0; ph < NPHASES; ++ph) { a.ph_lo = ph; a.ph_hi = ph + 1; hipLaunchKernelGGL(hymba_fwd, dim3(grid), dim3(512), LDS_BYTES, stream, a); }
#else
    a.ph_lo = 0; a.ph_hi = NPHASES;
    void* args[] = {&a};
    hipError_t e = hipLaunchCooperativeKernel((const void*)hymba_fwd, dim3(grid), dim3(512), args, LDS_BYTES, stream);
    if (e != hipSuccess) fprintf(stderr, "kernel_launch: cooperative launch failed: %s (grid %d)\n", hipGetErrorString(e), grid);
#endif
}
```

```cpp
#include <hip/hip_runtime.h>
#include <hip/hip_cooperative_groups.h>
#include <cstdio>
#include <cstdint>
namespace cg = cooperative_groups;
__device__ __forceinline__ int my_tid() { int t = threadIdx.x; asm volatile("" : "+v"(t)); return t; }
namespace pg8 {
#define PG8_LAS __attribute__((address_space(3)))
typedef unsigned short bf16_t;
typedef short bf16x8 __attribute__((ext_vector_type(8)));
typedef float f32x4 __attribute__((ext_vector_type(4)));
typedef unsigned u32x4 __attribute__((ext_vector_type(4)));
constexpr int BM = 256, BK = 64, HALF = 128, HTB = HALF * BK * 2  , STAGE_BYTES = 8 * HTB, NXCD = 8, WGM = 8;

__host__ __device__ __forceinline__ int lds_byte(int r, int c) { const int st = (r >> 4) * 2 + (c >> 5), rr = r & 15, cc = c & 31, ob = rr * 64 + cc * 2; return st * 1024 + (ob ^ (((ob >> 9) & 1) << 5)); }
__host__ __device__ __forceinline__ void stage_rc(int b, int& R, int& C) { const int st = b / 1024, sb = b % 1024, swz = sb ^ (((sb >> 9) & 1) << 5); R = (st >> 1) * 16 + swz / 64; C = (st & 1) * 32 + (swz % 64) / 2; }
__host__ __device__ __forceinline__ int perm32(int rho) { const int n = rho >> 4, i = rho & 15; return 8 * (i >> 2) + 4 * n + (i & 3); }

struct Unit { int pm, pn, idx; };
struct Gemm { const bf16_t* A; const bf16_t* Bt; int M, N, K; };

struct StaticOrder {
    int nM, nN, nwg, G, c;
    __host__ __device__ void init(int M, int N, int G_, int c_) { nM = M / BM; nN = N / BM; nwg = nM * nN; G = G_; c = c_; }
    __host__ __device__ bool next(int i, Unit& u) const {
        const long L = (long)i * G + c; if (L >= nwg) return false;
        int wgid = (int)L; { const int q = nwg / NXCD, r = nwg % NXCD, xcd = wgid % NXCD, off = wgid / NXCD; wgid = (xcd < r ? xcd * (q + 1) : r * (q + 1) + (xcd - r) * q) + off; }
        const int nig = WGM * nN, gid = wgid / nig, fm = gid * WGM, gsz = (nM - fm) < WGM ? (nM - fm) : WGM;
        u.pm = fm + ((wgid % nig) % gsz); u.pn = (wgid % nig) / gsz; u.idx = i; return true;
    }
    __device__ __forceinline__ void a_ready(const Unit&) const {}
    __device__ __forceinline__ void done(const Unit&) const {}
};
typedef float f32x2_cvt __attribute__((ext_vector_type(2))); typedef __bf16 bf16x2_cvt __attribute__((ext_vector_type(2)));
__device__ __forceinline__ unsigned cvt_pk_bf16(float lo, float hi) { const f32x2_cvt v = {lo, hi}; const bf16x2_cvt b = __builtin_convertvector(v, bf16x2_cvt); return __builtin_bit_cast(unsigned, b); }
__device__ __forceinline__ float fast_sigmoid(float x) { return __builtin_amdgcn_rcpf(1.0f + __expf(-x)); }
__device__ __forceinline__ float fast_silu(float x) { return x * fast_sigmoid(x); }
constexpr float QSCALE2 = 0.125f * 1.4426950408889634f;

__device__ __forceinline__ float row_sumsq(const float* RSQ, int row) {
    const f32x4* p = (const f32x4*)(RSQ + (size_t)row * 16);
    const f32x4 a = p[0], b = p[1], c = p[2], d = p[3];
    const f32x4 t = (a + b) + (c + d);
    return (t[0] + t[1]) + (t[2] + t[3]);
}
__device__ __forceinline__ float row_rstd(const float* RSQ, int row) { return __builtin_amdgcn_rsqf(row_sumsq(RSQ, row) * (1.0f / 1024.0f) + 1e-6f); }
__device__ __forceinline__ float row_rstd4(const float* RSQ, int row, int fq) {
    const f32x4 a = *((const f32x4*)(RSQ + (size_t)row * 16) + fq);
    float t = (a[0] + a[1]) + (a[2] + a[3]);
    t += __shfl_xor(t, 16); t += __shfl_xor(t, 32);
    return __builtin_amdgcn_rsqf(t * (1.0f / 1024.0f) + 1e-6f);
}
struct EpiWin {
    static constexpr bool PERM = true, AFTER_DRAIN = false;
    bf16_t *ACONV, *Q, *KCR, *VCR, *KS, *KW; float* G; const PG8_LAS float* RS;
    __device__ __forceinline__ void operator()(const f32x4 (&acc)[2][2][4][2], const Unit& u, int wr, int wc, int fr, int fq) const {
        const int pn = u.pn;
        const int R0 = u.pm * BM + wr * 64 + fr, c0 = wc * 32 + 8 * fq;
        if (pn == 9) {
#pragma unroll
            for (int ai = 0; ai < 2; ++ai)
#pragma unroll
                for (int m = 0; m < 4; ++m) {
                    const float rs = RS[u.idx * 256 + wr * 64 + fr + ai * HALF + m * 16];
                    if (c0 < 36) {
                        float* gp = G + (size_t)(R0 + ai * HALF + m * 16) * 36 + c0;
                        const f32x4 v0 = acc[ai][0][m][0] * rs, v1 = acc[ai][0][m][1] * rs;
#pragma unroll
                        for (int e = 0; e < 4; ++e) { gp[e] = fast_sigmoid(v0[e]); if (c0 + 4 + e < 36) gp[4 + e] = fast_sigmoid(v1[e]); }
                    }
                }
            return;
        }
        bf16_t* P0; int SA, SM, SB; float sc = 1.0f;
        if (pn < 2) { P0 = ACONV + (size_t)R0 * 512 + pn * 256 + c0; SA = 128 * 512; SM = 16 * 512; SB = 128; }
        else if (pn < 5) { P0 = Q + (size_t)R0 * 768 + (pn - 2) * 256 + c0; SA = 128 * 768; SM = 16 * 768; SB = 128; sc = QSCALE2; }
        else if (pn < 7) { P0 = (pn == 5 ? KCR : VCR) + (size_t)(R0 >> 4) * 4096 + (R0 & 15) * 64 + (c0 >> 6) * 1024 + (c0 & 63); SA = 8 * 4096; SM = 4096; SB = 2 * 1024; }
        else { P0 = (pn == 7 ? KS : KW) + (size_t)(R0 >> 12) * (4 * 4096 * 64) + (size_t)(R0 & 4095) * 64 + (size_t)(c0 >> 6) * (4096 * 64) + (c0 & 63); SA = 128 * 64; SM = 16 * 64; SB = 2 * 4096 * 64; }
#pragma unroll
        for (int ai = 0; ai < 2; ++ai)
#pragma unroll
            for (int m = 0; m < 4; ++m) {
                const float rs = RS[u.idx * 256 + wr * 64 + fr + ai * HALF + m * 16] * sc;
#pragma unroll
                for (int bj = 0; bj < 2; ++bj) {
                    const f32x4 v0 = acc[ai][bj][m][0] * rs, v1 = acc[ai][bj][m][1] * rs;
                    u32x4 w; w.x = cvt_pk_bf16(v0[0], v0[1]); w.y = cvt_pk_bf16(v0[2], v0[3]); w.z = cvt_pk_bf16(v1[0], v1[1]); w.w = cvt_pk_bf16(v1[2], v1[3]);
                    *(u32x4*)(P0 + (size_t)ai * SA + (size_t)m * SM + (size_t)bj * SB) = w;
                }
            }
    }
};
struct EpiVT {
    static constexpr bool PERM = false, AFTER_DRAIN = false;
    bf16_t *VST, *VWT; const PG8_LAS float* RS;
    __device__ __forceinline__ void operator()(const f32x4 (&acc)[2][2][4][2], const Unit& u, int wr, int wc, int fr, int fq) const {
        bf16_t* base = u.pn == 0 ? VST : VWT;
#pragma unroll
        for (int ai = 0; ai < 2; ++ai)
#pragma unroll
            for (int m = 0; m < 4; ++m) {
                const int row = u.pm * BM + ai * HALF + wr * 64 + m * 16 + 4 * fq;
                const int b = row >> 12, t = row & 4095;
                const f32x4 rs4 = *(const PG8_LAS f32x4*)(RS + u.idx * 256 + ai * HALF + wr * 64 + m * 16 + 4 * fq);
#pragma unroll
                for (int bj = 0; bj < 2; ++bj)
#pragma unroll
                    for (int n = 0; n < 2; ++n) {
                        const int col = bj * HALF + wc * 32 + n * 16 + fr, g = col >> 6, d = col & 63;
                        const f32x4 v = acc[ai][bj][m][n] * rs4;
                        unsigned long long w = (unsigned long long)cvt_pk_bf16(v[0], v[1]) | ((unsigned long long)cvt_pk_bf16(v[2], v[3]) << 32);
                        *(unsigned long long*)(base + ((size_t)(b * 4 + g) * 64 + d) * 4096 + t) = w;
                    }
            }
    }
};
struct EpiRes {
    static constexpr bool PERM = false, AFTER_DRAIN = false;
    bf16_t* XB; float* RSQ;
    __device__ __forceinline__ void operator()(const f32x4 (&acc)[2][2][4][2], const Unit& u, int wr, int wc, int fr, int fq) const {
#pragma unroll
        for (int ai = 0; ai < 2; ++ai)
#pragma unroll
            for (int m = 0; m < 4; ++m) {
                const int row = u.pm * BM + ai * HALF + wr * 64 + m * 16 + fr;
                bf16_t* xp = XB + (size_t)row * 1024 + u.pn * BM + wc * 32 + 4 * fq;
                unsigned long long b[2][2];
#pragma unroll
                for (int bj = 0; bj < 2; ++bj)
#pragma unroll
                    for (int n = 0; n < 2; ++n) b[bj][n] = *(const unsigned long long*)(xp + bj * HALF + n * 16);
                float ss = 0.f;
#pragma unroll
                for (int bj = 0; bj < 2; ++bj)
#pragma unroll
                    for (int n = 0; n < 2; ++n) {
                        const unsigned lo = (unsigned)b[bj][n], hi = (unsigned)(b[bj][n] >> 32);
                        f32x4 v = acc[ai][bj][m][n];
                        v[0] += __builtin_bit_cast(float, lo << 16); v[1] += __builtin_bit_cast(float, lo & 0xffff0000u);
                        v[2] += __builtin_bit_cast(float, hi << 16); v[3] += __builtin_bit_cast(float, hi & 0xffff0000u);
                        ss += (v[0] * v[0] + v[1] * v[1]) + (v[2] * v[2] + v[3] * v[3]);
                        *(unsigned long long*)(xp + bj * HALF + n * 16) = (unsigned long long)cvt_pk_bf16(v[0], v[1]) | ((unsigned long long)cvt_pk_bf16(v[2], v[3]) << 32);
                    }
                ss += __shfl_xor(ss, 16); ss += __shfl_xor(ss, 32);
                if (fq == 0) RSQ[(size_t)row * 16 + u.pn * 4 + wc] = ss;
            }
    }
};
struct EpiSwiglu {
    static constexpr bool PERM = true, AFTER_DRAIN = false;
    bf16_t* H; const PG8_LAS float* RS;
    __device__ __forceinline__ void operator()(const f32x4 (&acc)[2][2][4][2], const Unit& u, int wr, int wc, int fr, int fq) const {
#pragma unroll
        for (int ai = 0; ai < 2; ++ai)
#pragma unroll
            for (int m = 0; m < 4; ++m) {
                const int row = u.pm * BM + ai * HALF + wr * 64 + m * 16 + fr;
                const float rs = RS[u.idx * 256 + ai * HALF + wr * 64 + m * 16 + fr];
                const f32x4 g0 = acc[ai][0][m][0] * rs, g1 = acc[ai][0][m][1] * rs, u0 = acc[ai][1][m][0] * rs, u1 = acc[ai][1][m][1] * rs;
                float r[8];
#pragma unroll
                for (int e = 0; e < 4; ++e) { r[e] = fast_silu(g0[e]) * u0[e]; r[4 + e] = fast_silu(g1[e]) * u1[e]; }
                u32x4 w; w.x = cvt_pk_bf16(r[0], r[1]); w.y = cvt_pk_bf16(r[2], r[3]); w.z = cvt_pk_bf16(r[4], r[5]); w.w = cvt_pk_bf16(r[6], r[7]);
                *(u32x4*)(H + (size_t)row * 2816 + u.pn * 128 + wc * 32 + 8 * fq) = w;
            }
    }
};
struct EpiCmp {
    static constexpr bool PERM = false, AFTER_DRAIN = false;
    float* LOHI;
    __device__ __forceinline__ void operator()(const f32x4 (&acc)[2][2][4][2], const Unit& u, int wr, int wc, int fr, int fq) const {
#pragma unroll
        for (int ai = 0; ai < 2; ++ai)
#pragma unroll
            for (int m = 0; m < 4; ++m) {
                const size_t off = (size_t)(u.pm * BM + ai * HALF + wr * 64 + m * 16 + fr) * 512 + (u.pn & 1) * BM + wc * 32 + 4 * fq;
#pragma unroll
                for (int bj = 0; bj < 2; ++bj)
#pragma unroll
                    for (int n = 0; n < 2; ++n) *(f32x4*)(LOHI + off + bj * HALF + n * 16) = acc[ai][bj][m][n];
            }
    }
};
template <class Sched>
__device__ __forceinline__ void prep_rstd(const Sched& S, const float* RSQ, PG8_LAS float* RS, int tid) {
    Unit u;
    for (int i = 0; S.next(i, u); ++i)
        if ((tid >> 8) == (i & 1)) RS[i * 256 + (tid & 255)] = row_rstd(RSQ, u.pm * BM + (tid & 255));
    __syncthreads();
}
struct CmpOrder {
    int G, c;
    __device__ bool next(int i, Unit& u) const {
        u.idx = i;
        if (G == 256) {
            if (i > 0 || (c >> 3) >= 16) return false;
            const int b = c & 7, q = c >> 3, kv = q >> 3; u.pm = kv * 32 + b * 4 + ((q >> 1) & 3); u.pn = kv * 2 + (q & 1); return true;
        }
        const long L = (long)i * G + c; if (L >= 128) return false; u.pm = (int)(L >> 1); u.pn = ((u.pm >= 32) ? 2 : 0) + (int)(L & 1); return true; }
    __device__ __forceinline__ void a_ready(const Unit&) const {}
    __device__ __forceinline__ void done(const Unit&) const {}
};
template <class Epi, class Sched, bool ALIGN_EPI = false, bool SP2 = false, bool SWAP = false>
__device__ __forceinline__ void gemm_phase(PG8_LAS unsigned char* lds, const Gemm g, const Sched& S, const Epi& E) {
    const int tid = my_tid(), wid = __builtin_amdgcn_readfirstlane(tid >> 6), lane = tid & 63, wr = wid >> 2, wc = wid & 3, fr = lane & 15, fq = lane >> 4;
    const int K = g.K, nt = K / BK;
    unsigned voffA[2], voffB[2];
#pragma unroll
    for (int i = 0; i < 2; ++i) { int R, C; stage_rc(tid * 16 + i * 8192, R, C); const int Rb = Epi::PERM ? ((R & ~31) + perm32(R & 31)) : R;
        voffA[i] = (unsigned)(R * K + C) * 2u; voffB[i] = (unsigned)(Rb * K + C) * 2u; }
    const size_t kstep = (size_t)(BK * 2);
    const size_t hstep = (size_t)HALF * K * 2;
    const size_t tstep = 2 * hstep;
    const unsigned ldsw = (unsigned)wid * 1024u;
    const int aoff = lds_byte(wr * 64 + fr, fq * 8), boff = lds_byte(wc * 32 + fr, fq * 8);
#define PG8_SA(b, h) (((b) * 2 + (h)) * HTB)
#define PG8_SB(b, h) ((4 + (b) * 2 + (h)) * HTB)
#define PG8_STAGE(bufoff, gbase, voff) do { _Pragma("unroll") for (int _i = 0; _i < 2; ++_i) \
        __builtin_amdgcn_global_load_lds((const unsigned*)((const char*)(gbase) + (voff)[_i]), (PG8_LAS unsigned*)(lds + (bufoff) + ldsw + _i * 8192), 16, 0, 0); } while (0)
#define PG8_LDA(dst, b, h) do { _Pragma("unroll") for (int m = 0; m < 4; ++m) _Pragma("unroll") for (int k = 0; k < 2; ++k) dst[m][k] = *(const PG8_LAS bf16x8*)(lds + PG8_SA(b, h) + aoff + m * 2048 + k * 1024); } while (0)
#define PG8_LDB(dst, b, h) do { _Pragma("unroll") for (int n = 0; n < 2; ++n) _Pragma("unroll") for (int k = 0; k < 2; ++k) dst[n][k] = *(const PG8_LAS bf16x8*)(lds + PG8_SB(b, h) + boff + n * 2048 + k * 1024); } while (0)
#define PG8_MMA(ai, bj, At, Bt) do { __builtin_amdgcn_s_setprio(1); _Pragma("unroll") for (int m = 0; m < 4; ++m) _Pragma("unroll") for (int n = 0; n < 2; ++n) _Pragma("unroll") for (int k = 0; k < 2; ++k) \
        acc[ai][bj][m][n] = SWAP ? __builtin_amdgcn_mfma_f32_16x16x32_bf16(At[m][k], Bt[n][k], acc[ai][bj][m][n], 0, 0, 0) : __builtin_amdgcn_mfma_f32_16x16x32_bf16(Bt[n][k], At[m][k], acc[ai][bj][m][n], 0, 0, 0); __builtin_amdgcn_s_setprio(0); } while (0)
#define PG8_WAIT_V(n) asm volatile("s_waitcnt vmcnt(" #n ")" ::: "memory")
#define PG8_WAIT_L(n) asm volatile("s_waitcnt lgkmcnt(" #n ")" ::: "memory")
#define PG8_BAR __builtin_amdgcn_s_barrier()
#define PG8_SCHED __builtin_amdgcn_sched_barrier(0)
    Unit cur, nxt; int ui = 0;
    if (!S.next(0, cur)) return;
    f32x4 acc[2][2][4][2];
#pragma unroll
    for (int a = 0; a < 2; ++a)
#pragma unroll
        for (int b = 0; b < 2; ++b)
#pragma unroll
            for (int m = 0; m < 4; ++m)
#pragma unroll
                for (int n = 0; n < 2; ++n) acc[a][b][m][n] = (f32x4){0.f, 0.f, 0.f, 0.f};
    bf16x8 At[4][2], B0[2][2], B1[2][2];
    const char* cA = (const char*)g.A + (size_t)cur.pm * tstep; const char* cB = (const char*)g.Bt + (size_t)cur.pn * tstep;
    S.a_ready(cur);
    if constexpr (SP2) {
        PG8_STAGE(PG8_SB(0, 0), cB, voffB); PG8_STAGE(PG8_SB(0, 1), cB + hstep, voffB); PG8_STAGE(PG8_SA(0, 0), cA, voffA); PG8_STAGE(PG8_SA(0, 1), cA + hstep, voffA);
        if (wr == 1) PG8_BAR;
        PG8_WAIT_V(2); PG8_BAR;
        PG8_STAGE(PG8_SB(1, 0), cB + kstep, voffB); PG8_STAGE(PG8_SA(1, 0), cA + kstep, voffA); PG8_STAGE(PG8_SB(1, 1), cB + hstep + kstep, voffB);
        PG8_WAIT_V(6); PG8_BAR;
    } else {
        PG8_STAGE(PG8_SB(0, 0), cB, voffB); PG8_STAGE(PG8_SA(0, 0), cA, voffA); PG8_STAGE(PG8_SB(0, 1), cB + hstep, voffB); PG8_STAGE(PG8_SA(0, 1), cA + hstep, voffA);
        if (wr == 1) PG8_BAR;
        PG8_WAIT_V(4); PG8_BAR;
        PG8_STAGE(PG8_SB(1, 0), cB + kstep, voffB); PG8_STAGE(PG8_SA(1, 0), cA + kstep, voffA); PG8_STAGE(PG8_SB(1, 1), cB + hstep + kstep, voffB);
        PG8_WAIT_V(6); PG8_BAR;
    }
    for (;;) {
        const bool has_next = S.next(ui + 1, nxt);
        const char* nA = has_next ? (const char*)g.A + (size_t)nxt.pm * tstep : cA; const char* nB = has_next ? (const char*)g.Bt + (size_t)nxt.pn * tstep : cB;
        for (int t = 0; t < nt; t += 2) {
            const bool last = (t == nt - 2);
            const char* a1 = cA + (size_t)(t + 1) * kstep;
            const char* a2 = last ? nA : cA + (size_t)(t + 2) * kstep; const char* b2 = last ? nB : cB + (size_t)(t + 2) * kstep;
            const char* a3 = a2 + kstep; const char* b3 = b2 + kstep;
            if (last && has_next) S.a_ready(nxt);
            if constexpr (SP2) {
            PG8_LDB(B0, 0, 0); PG8_LDB(B1, 0, 1); PG8_SCHED; PG8_LDA(At, 0, 0); PG8_STAGE(PG8_SA(1, 1), a1 + hstep, voffA);
            PG8_WAIT_V(8); PG8_WAIT_L(0); PG8_BAR; PG8_MMA(0, 0, At, B0); PG8_MMA(0, 1, At, B1); PG8_BAR; PG8_SCHED;
            PG8_LDA(At, 0, 1); PG8_STAGE(PG8_SB(0, 0), b2, voffB); PG8_STAGE(PG8_SB(0, 1), b2 + hstep, voffB); PG8_STAGE(PG8_SA(0, 0), a2, voffA);
            PG8_WAIT_V(8); PG8_WAIT_L(0); PG8_BAR; PG8_MMA(1, 0, At, B0); PG8_MMA(1, 1, At, B1); PG8_BAR; PG8_SCHED;
            PG8_LDB(B0, 1, 0); PG8_LDB(B1, 1, 1); PG8_SCHED; PG8_LDA(At, 1, 0); PG8_STAGE(PG8_SA(0, 1), a2 + hstep, voffA);
            PG8_WAIT_V(8); PG8_WAIT_L(0); PG8_BAR; PG8_MMA(0, 0, At, B0); PG8_MMA(0, 1, At, B1); PG8_BAR; PG8_SCHED;
            PG8_LDA(At, 1, 1); PG8_STAGE(PG8_SB(1, 0), b3, voffB); PG8_STAGE(PG8_SB(1, 1), b3 + hstep, voffB); PG8_STAGE(PG8_SA(1, 0), a3, voffA);
            PG8_WAIT_V(8); PG8_WAIT_L(0); PG8_BAR; PG8_MMA(1, 0, At, B0); PG8_MMA(1, 1, At, B1); PG8_BAR; PG8_SCHED;
            } else {
            PG8_LDB(B0, 0, 0); PG8_SCHED; PG8_LDA(At, 0, 0); PG8_STAGE(PG8_SA(1, 1), a1 + hstep, voffA);
            PG8_WAIT_L(8); PG8_BAR; PG8_WAIT_L(0); PG8_MMA(0, 0, At, B0); PG8_BAR; PG8_SCHED;
            PG8_LDB(B1, 0, 1); PG8_STAGE(PG8_SB(0, 0), b2, voffB);
            PG8_BAR; PG8_WAIT_L(0); PG8_MMA(0, 1, At, B1); PG8_BAR;
            PG8_LDA(At, 0, 1); PG8_STAGE(PG8_SA(0, 0), a2, voffA);
            PG8_BAR; PG8_WAIT_L(0); PG8_MMA(1, 0, At, B0); PG8_BAR; PG8_SCHED;
            PG8_STAGE(PG8_SB(0, 1), b2 + hstep, voffB);
            PG8_WAIT_V(6); PG8_BAR; PG8_MMA(1, 1, At, B1); PG8_BAR;
            PG8_LDB(B0, 1, 0); PG8_SCHED; PG8_LDA(At, 1, 0); PG8_STAGE(PG8_SA(0, 1), a2 + hstep, voffA);
            PG8_WAIT_L(8); PG8_BAR; PG8_WAIT_L(0); PG8_MMA(0, 0, At, B0); PG8_BAR; PG8_SCHED;
            PG8_LDB(B1, 1, 1); PG8_STAGE(PG8_SB(1, 0), b3, voffB);
            PG8_BAR; PG8_WAIT_L(0); PG8_MMA(0, 1, At, B1); PG8_BAR;
            PG8_LDA(At, 1, 1); PG8_STAGE(PG8_SA(1, 0), a3, voffA);
            PG8_BAR; PG8_WAIT_L(0); PG8_MMA(1, 0, At, B0); PG8_BAR; PG8_SCHED;
            PG8_STAGE(PG8_SB(1, 1), b3 + hstep, voffB);
            PG8_WAIT_V(6); PG8_BAR; PG8_MMA(1, 1, At, B1); PG8_BAR;
            }
        }
        if constexpr (ALIGN_EPI) { if (wr == 0) PG8_BAR; }
        if constexpr (!Epi::AFTER_DRAIN) { E(acc, cur, wr, wc, fr, fq); S.done(cur); }
        if (!has_next) break;
#pragma unroll
        for (int a = 0; a < 2; ++a)
#pragma unroll
            for (int b = 0; b < 2; ++b)
#pragma unroll
                for (int m = 0; m < 4; ++m)
#pragma unroll
                    for (int n = 0; n < 2; ++n) acc[a][b][m][n] = (f32x4){0.f, 0.f, 0.f, 0.f};
        cur = nxt; cA = nA; cB = nB; ++ui;
        if constexpr (ALIGN_EPI) { if (wr == 1) PG8_BAR; }
    }
    PG8_WAIT_V(0);
    if constexpr (!ALIGN_EPI) { if (wr == 0) PG8_BAR; }
    PG8_BAR;
    if constexpr (Epi::AFTER_DRAIN) { E.fused(acc, cur, wr, wc, fr, fq, lds, wid, lane); S.done(cur); }
#undef PG8_SA
#undef PG8_SB
#undef PG8_STAGE
#undef PG8_LDA
#undef PG8_LDB
#undef PG8_MMA
#undef PG8_WAIT_V
#undef PG8_WAIT_L
#undef PG8_BAR
#undef PG8_SCHED
}
}
#define LAS __attribute__((address_space(3)))
typedef unsigned short bf16;
typedef short bf16x8 __attribute__((ext_vector_type(8)));
typedef short s16x4 __attribute__((ext_vector_type(4)));
typedef float f32x4 __attribute__((ext_vector_type(4)));
typedef unsigned u32x4 __attribute__((ext_vector_type(4)));
typedef unsigned u32x2 __attribute__((ext_vector_type(2)));

constexpr int NB = 8, T = 4096, D = 1024, M = NB * T, DEPTH = 4;
constexpr int IN_COLS = 2852, DFF = 2816;
constexpr float EPS = 1e-6f;
constexpr float LOG2E = 1.4426950408889634f;
constexpr size_t MiB = 1u << 20;
constexpr size_t WS_X = 0, WS_XN = 128 * MiB, WS_ACONV = 192 * MiB, WS_Q = 224 * MiB, WS_KCR = 272 * MiB, WS_VCR = 288 * MiB, WS_KS = 304 * MiB, WS_KW = 320 * MiB,
                 WS_VST = 336 * MiB, WS_VWT = 352 * MiB, WS_HFF = 192 * MiB,
                 WS_WSET = 368 * MiB, WSET_BYTES = 27 * MiB,
                 OFF_WIN = 0, OFF_WOUT = 6 * MiB, OFF_WGU = 8 * MiB, OFF_WD = 19 * MiB, OFF_CMPW = 25 * MiB,
                 WS_XB = 422 * MiB, WS_LOHI = 0, WS_ASCR = 32 * MiB,
                 WS_G = 486 * MiB, WS_KC = 491 * MiB, WS_VCT = 492 * MiB, WS_PE = 493 * MiB, WS_RSQ = 494 * MiB, WS_CTL = 498 * MiB, WS_END = 499 * MiB;
constexpr int LDS_BYTES = 163840, MISC_OFF = 163840 - 512, CTL_ZERO_BYTES = 16384;
constexpr int NPH = 11, NPHASES = DEPTH * NPH + 1;

struct Args {
    const float* in[18]; float* out; unsigned char* ws; int ph_lo, ph_hi;
};
#ifndef USE_PT
#define USE_PT 0
#endif
struct PT {
    LAS const unsigned long long* t; unsigned char* ws; const Args* ap;
#if USE_PT
    __device__ __forceinline__ unsigned long long raw(int i) const { const unsigned long long v = t[i]; return (unsigned long long)__builtin_amdgcn_readfirstlane((unsigned)v) | ((unsigned long long)__builtin_amdgcn_readfirstlane((unsigned)(v >> 32)) << 32); }
#else
    __device__ __forceinline__ unsigned long long raw(int i) const { return i < 18 ? (unsigned long long)ap->in[i] : (i == 18 ? (unsigned long long)ap->out : (unsigned long long)ap->ws); }
#endif
    __device__ __forceinline__ const float* in(int i) const { return (const float*)raw(i); }
};

__device__ __forceinline__ unsigned f2bf(float f) { unsigned u = __builtin_bit_cast(unsigned, f); return (u + 0x7fffu + ((u >> 16) & 1u)) >> 16; }
typedef float f32x2_cv __attribute__((ext_vector_type(2))); typedef __bf16 bf16x2_cv __attribute__((ext_vector_type(2)));
__device__ __forceinline__ unsigned pk2(float lo, float hi) { const f32x2_cv v = {lo, hi}; const bf16x2_cv b = __builtin_convertvector(v, bf16x2_cv); return __builtin_bit_cast(unsigned, b); }
__device__ __forceinline__ float bf2f(unsigned short h) { return __builtin_bit_cast(float, (unsigned)h << 16); }
__device__ __forceinline__ float wave_sum(float v) {
#pragma unroll
    for (int o = 1; o < 64; o <<= 1) v += __shfl_xor(v, o);
    return v;
}
#define LDS_WAIT() asm volatile("s_waitcnt lgkmcnt(0)" ::: "memory")

__device__ __forceinline__ void transpose_item(const float* W, int ldw, int ncols, bf16* WTrow0, int ldt, LAS float* scr, int k0, int n0, int lane, const float* gain = nullptr) {
    const int cq = lane & 15, kr = lane >> 4;
#pragma unroll 8
    for (int i = 0; i < 16; ++i) {
        const int kk = 4 * i + kr, n = n0 + 4 * cq;
        f32x4 v = {0.f, 0.f, 0.f, 0.f};
        if (n < ncols) v = *(const f32x4*)(W + (size_t)(k0 + kk) * ldw + n);
        LAS float* d = scr + kk * 65 + 4 * cq;
        d[0] = v[0]; d[1] = v[1]; d[2] = v[2]; d[3] = v[3];
    }
    LDS_WAIT(); asm volatile("" ::: "memory");
    const int c = lane & 7;
    f32x4 ga = {1.f, 1.f, 1.f, 1.f}, gb = ga;
    if (gain) { ga = *(const f32x4*)(gain + k0 + 8 * c); gb = *(const f32x4*)(gain + k0 + 8 * c + 4); }
#pragma unroll
    for (int j = 0; j < 8; ++j) { const int n = (lane >> 3) + 8 * j; const LAS float* s = scr + (8 * c) * 65 + n;
        u32x4 o; o.x = pk2(s[0 * 65] * ga[0], s[1 * 65] * ga[1]); o.y = pk2(s[2 * 65] * ga[2], s[3 * 65] * ga[3]); o.z = pk2(s[4 * 65] * gb[0], s[5 * 65] * gb[1]); o.w = pk2(s[6 * 65] * gb[2], s[7 * 65] * gb[3]);
        *(u32x4*)(WTrow0 + (size_t)n * ldt + k0 + 8 * c) = o; }
    LDS_WAIT(); asm volatile("" ::: "memory");
}
__device__ __forceinline__ int win_row(int n0) {
    if (n0 < 2048) return n0;
    if (n0 < 2304) return 2560 + (n0 - 2048);
    if (n0 < 2560) return 2048 + (n0 - 2304);
    if (n0 < 2816) return 2816 + (n0 - 2560);
    return 2304 + (n0 - 2816);
}
__device__ __forceinline__ int wgu_row(int n0) { const int h = n0 < DFF ? n0 : n0 - DFF; return 256 * (h >> 7) + (h & 127) + (n0 < DFF ? 0 : 128); }

__device__ __forceinline__ void prologue_layer(const PT& a, int layer, LAS unsigned char* lds, int blk, int G) {
    const int tid = my_tid(), lane = tid & 63, wave = tid >> 6;
    LAS float* scr = (LAS float*)(lds + wave * 17408);
    const int gw = blk * 8 + wave, NGW = G * 8;
    unsigned char* ws = a.ws; unsigned char* wset = ws + WS_WSET + (size_t)(layer & 1) * WSET_BYTES;
    bf16* WIN = (bf16*)(wset + OFF_WIN); bf16* WOUT = (bf16*)(wset + OFF_WOUT); bf16* WGU = (bf16*)(wset + OFF_WGU); bf16* WD = (bf16*)(wset + OFF_WD); bf16* CMPW = (bf16*)(wset + OFF_CMPW);
    const float* g1 = a.in(1) + (size_t)layer * D; const float* g2 = a.in(14) + (size_t)layer * D;
    const float* w_in = a.in(2) + (size_t)layer * D * IN_COLS;
    const float* w_out = a.in(13) + (size_t)layer * D * D;
    const float* w_gu = a.in(15) + (size_t)layer * D * 2 * DFF;
    const float* w_dn = a.in(16) + (size_t)layer * DFF * D;
    const float* kw1 = a.in(8) + (size_t)layer * 32 * 64 * 256;
    const float* vw1 = a.in(11) + (size_t)layer * 32 * 64 * 256;
    constexpr int I_IN = 16 * 45, I_OUT = 16 * 16, I_GU = 16 * 88, I_DN = 44 * 16, I_C = 16 * 4;
    constexpr int NIT = I_IN + I_OUT + I_GU + I_DN + 4 * I_C;
    for (int it = gw; it < NIT; it += NGW) {
        int r = it;
        if (r < I_IN) { const int kb = r / 45, nb = r % 45; transpose_item(w_in, IN_COLS, IN_COLS, WIN + (size_t)win_row(64 * nb) * D, D, scr, 64 * kb, 64 * nb, lane, g1); continue; } r -= I_IN;
        if (r < I_OUT) { const int kb = r / 16, nb = r % 16; transpose_item(w_out, D, D, WOUT + (size_t)(64 * nb) * D, D, scr, 64 * kb, 64 * nb, lane); continue; } r -= I_OUT;
        if (r < I_GU) { const int kb = r / 88, nb = r % 88; transpose_item(w_gu, 2 * DFF, 2 * DFF, WGU + (size_t)wgu_row(64 * nb) * D, D, scr, 64 * kb, 64 * nb, lane, g2); continue; } r -= I_GU;
        if (r < I_DN) { const int kb = r / 16, nb = r % 16; transpose_item(w_dn, D, D, WD + (size_t)(64 * nb) * DFF, DFF, scr, 64 * kb, 64 * nb, lane); continue; } r -= I_DN;
        { const int q = r / I_C, rr = r % I_C, kb = rr / 4, nb = rr % 4;
          const float* src = ((q < 2) ? kw1 : vw1) + (size_t)(q & 1) * 1024 * 256;
          transpose_item(src, 256, 256, CMPW + (size_t)(q * 256 + 64 * nb) * D, D, scr, 64 * kb, 64 * nb, lane); }
    }
    { u32x4 z = {0u, 0u, 0u, 0u}; u32x4* p = (u32x4*)(WIN + (size_t)(2304 + 64) * D);
      for (int i = blk * 512 + tid; i < 192 * D / 8; i += G * 512) p[i] = z; }
    if (blk < 16) {
        __syncthreads();
        const int kvb = blk >> 3, cg = blk & 7;
        const float* pe = (kvb == 0 ? a.in(7) : a.in(10)) + (size_t)layer * 2048;
        const float* w1 = kvb == 0 ? kw1 : vw1;
        LAS float* red = (LAS float*)lds;
        const int c = tid & 31, lg = tid >> 5;
        float s = 0.f;
#pragma unroll 16
        for (int i = 0; i < 128; ++i) { const int ld = lg * 128 + i; s += pe[ld] * w1[(size_t)ld * 256 + cg * 32 + c]; }
        red[lg * 32 + c] = s;
        __syncthreads();
        if (tid < 32) { float t = 0.f;
#pragma unroll
            for (int j = 0; j < 16; ++j) t += red[j * 32 + tid];
            ((float*)(ws + WS_PE))[(layer & 1) * 512 + kvb * 256 + cg * 32 + tid] = t; }
        __syncthreads();
    }
}

__device__ __forceinline__ void first_rows(const float* x, bf16* XB, float* RSQ, int blk, int G) {
    const int tid = my_tid(), lane = tid & 63, wave = tid >> 6;
    const int gw = blk * 8 + wave, NGW = G * 8;
    for (int m = gw; m < M; m += NGW) {
        const f32x4* xr = (const f32x4*)(x + (size_t)m * D) + lane;
        unsigned long long* o8 = (unsigned long long*)(XB + (size_t)m * D) + lane;
        float s = 0.f;
#pragma unroll
        for (int j = 0; j < 4; ++j) { const f32x4 v = xr[64 * j]; s += (v.x * v.x + v.y * v.y) + (v.z * v.z + v.w * v.w); o8[64 * j] = (unsigned long long)pk2(v.x, v.y) | ((unsigned long long)pk2(v.z, v.w) << 32); }
        s = wave_sum(s);
        if (lane < 16) RSQ[(size_t)m * 16 + lane] = lane == 0 ? s : 0.f;
    }
}
__device__ __forceinline__ void final_rows(const bf16* xb, const float* RSQ, const float* gain, float* out, int blk, int G) {
    const int tid = my_tid(), lane = tid & 63, wave = tid >> 6;
    const int gw = blk * 8 + wave, NGW = G * 8;
    f32x4 gv[4];
#pragma unroll
    for (int j = 0; j < 4; ++j) gv[j] = *((const f32x4*)gain + lane + 64 * j);
    for (int m = gw; m < M; m += NGW) {
        const float rstd = 1.0f / sqrtf(pg8::row_sumsq(RSQ, m) * (1.f / D) + EPS);
        const unsigned long long* xr = (const unsigned long long*)(xb + (size_t)m * D) + lane;
        f32x4* o = (f32x4*)(out + (size_t)m * D) + lane;
#pragma unroll
        for (int j = 0; j < 4; ++j) {
            const unsigned long long w = xr[64 * j]; const unsigned lo = (unsigned)w, hi = (unsigned)(w >> 32);
            const f32x4 v = {__builtin_bit_cast(float, lo << 16), __builtin_bit_cast(float, lo & 0xffff0000u), __builtin_bit_cast(float, hi << 16), __builtin_bit_cast(float, hi & 0xffff0000u)};
            o[64 * j] = v * rstd * gv[j];
        }
    }
}

__device__ __forceinline__ void conv_phase(const PT& a, int layer, LAS unsigned char* lds, int blk, int G) {
    const int tid = my_tid(), lane = tid & 63, wave = tid >> 6;
    LAS float* Y = (LAS float*)lds;
    LAS float* C = Y + 62 * 256;
    const bf16* ACONV = (const bf16*)(a.ws + WS_ACONV);
    bf16* MIX = (bf16*)(a.ws + WS_XN);
    const float* cw = a.in(3) + (size_t)layer * 31 * 256;
    const float* cb = a.in(4) + (size_t)layer * 256;
    const float* lg = a.in(5) + (size_t)layer * 256;
    const float* lb = a.in(6) + (size_t)layer * 256;
    const int c = tid & 255, half = tid >> 8;
    float w[31];
#pragma unroll
    for (int k = 0; k < 31; ++k) w[k] = cw[k * 256 + c];
    const float bias = cb[c];
    const f32x4 g4 = *((const f32x4*)lg + lane), b4 = *((const f32x4*)lb + lane);
    const int cq = blk >> 3, cnt = (G == 256) ? (cq < 16 ? 2 : 6) : 0, tbase = (blk & 7) * 128 + (cq < 16 ? 2 * cq : 32 + 6 * (cq - 16));
    u32x4 ru[4], rv[4];
#define CONV_FETCH(tile_) do { const int b_ = (tile_) >> 7, t0_ = ((tile_) & 127) * 32; \
        _Pragma("unroll") for (int k_ = 0; k_ < 4; ++k_) { const int idx_ = tid + 512 * k_; const int t_ = t0_ - 30 + (idx_ >> 5); \
            ru[k_] = (u32x4){0u, 0u, 0u, 0u}; rv[k_] = ru[k_]; \
            if (idx_ < 62 * 32 && t_ >= 0) { const bf16* p_ = ACONV + ((size_t)b_ * T + t_) * 512 + (idx_ & 31) * 8; ru[k_] = *(const u32x4*)p_; rv[k_] = *(const u32x4*)(p_ + 256); } } } while (0)
    const int tl0 = (G == 256) ? 0 : blk, tlim = (G == 256) ? cnt : 1024, tstep = (G == 256) ? 1 : G;
    if (tl0 < tlim) CONV_FETCH((G == 256) ? tbase + tl0 : tl0);
    for (int tl = tl0; tl < tlim; tl += tstep) {
        const int tile = (G == 256) ? tbase + tl : tl;
        const int b = tile >> 7, t0 = (tile & 127) * 32;
#pragma unroll
        for (int k = 0; k < 4; ++k) {
            const int idx = tid + 512 * k;
            if (idx < 62 * 32) {
                const int rr = idx >> 5, ch = idx & 31;
                f32x4 y0, y1;
                const u32x4 u = ru[k], v = rv[k];
#pragma unroll
                for (int e = 0; e < 4; ++e) {
                    const float ulo = __builtin_bit_cast(float, u[e] << 16), uhi = __builtin_bit_cast(float, u[e] & 0xffff0000u);
                    const float vlo = __builtin_bit_cast(float, v[e] << 16), vhi = __builtin_bit_cast(float, v[e] & 0xffff0000u);
                    const float r0 = ulo * pg8::fast_sigmoid(vlo), r1 = uhi * pg8::fast_sigmoid(vhi);
                    if (e < 2) { y0[2 * e] = r0; y0[2 * e + 1] = r1; } else { y1[2 * (e - 2)] = r0; y1[2 * (e - 2) + 1] = r1; }
                }
                *(LAS f32x4*)(Y + rr * 256 + ch * 8) = y0; *(LAS f32x4*)(Y + rr * 256 + ch * 8 + 4) = y1;
            }
        }
        __syncthreads();
        if (tl + tstep < tlim) CONV_FETCH((G == 256) ? tbase + tl + tstep : tl + tstep);
        {
            float acc[16];
#pragma unroll
            for (int tt = 0; tt < 16; ++tt) acc[tt] = bias;
#pragma unroll
            for (int r2 = 0; r2 < 46; ++r2) {
                const float yv = Y[(half * 16 + r2) * 256 + c];
#pragma unroll
                for (int tt = 0; tt < 16; ++tt) { const int k = r2 - tt; if (k >= 0 && k <= 30) acc[tt] += w[k] * yv; }
            }
#pragma unroll
            for (int tt = 0; tt < 16; ++tt) C[(half * 16 + tt) * 256 + c] = acc[tt];
        }
        __syncthreads();
#pragma unroll
        for (int i = 0; i < 4; ++i) {
            const int tok = wave * 4 + i;
            const f32x4 v = *(const LAS f32x4*)(C + tok * 256 + lane * 4);
            const float mu = wave_sum((v.x + v.y) + (v.z + v.w)) * (1.f / 256.f);
            const f32x4 dv = v - mu;
            const float var = wave_sum((dv.x * dv.x + dv.y * dv.y) + (dv.z * dv.z + dv.w * dv.w)) * (1.f / 256.f);
            const float rstd = 1.0f / sqrtf(var + EPS);
            f32x4 y = dv * rstd * g4 + b4;
            y.x = pg8::fast_silu(y.x); y.y = pg8::fast_silu(y.y); y.z = pg8::fast_silu(y.z); y.w = pg8::fast_silu(y.w);
            *(unsigned long long*)(MIX + ((size_t)b * T + t0 + tok) * D + lane * 4) = (unsigned long long)pk2(y.x, y.y) | ((unsigned long long)pk2(y.z, y.w) << 32);
        }
    }
    __syncthreads();
}

__device__ __forceinline__ void cmp2_phase(const PT& a, int layer, LAS unsigned char* lds, int blk, int G) {
    const int tid = my_tid(), lane = tid & 63, wave = tid >> 6;
    LAS float* hL = (LAS float*)(lds + wave * 4096);
    LAS float* W2L = (LAS float*)(lds + 32768);
    const float* LOHI = (const float*)(a.ws + WS_LOHI);
    const float* PE = (const float*)(a.ws + WS_PE) + (layer & 1) * 512;
    bf16* KC = (bf16*)(a.ws + WS_KC); bf16* VCT = (bf16*)(a.ws + WS_VCT);
    const int gw = blk * 8 + wave, NGW = G * 8;
    const int nround = (G == 256) ? 2 : (2 * NB * 255 + NGW - 1) / NGW;
    for (int rd = 0; rd < nround; ++rd) {
        int kv, b, n; bool act;
        if (G == 256) {
            const int lw = (blk >> 3) * 8 + wave; kv = rd; b = blk & 7; n = lw; act = lw < 255;
            const float* w2g = (kv == 0 ? a.in(9) : a.in(12)) + (size_t)layer * 256 * 64;
            __syncthreads();
#pragma unroll
            for (int i = 0; i < 8; ++i) *(LAS f32x4*)(W2L + (tid + 512 * i) * 4) = *((const f32x4*)w2g + tid + 512 * i);
            __syncthreads();
        } else { const int gi = gw + rd * NGW; act = gi < 2 * NB * 255; kv = act ? gi / (NB * 255) : 0; const int rem = act ? gi % (NB * 255) : 0; b = rem / 255; n = rem % 255; }
        if (!act) continue;
        const float* w2 = (kv == 0 ? a.in(9) : a.in(12)) + (size_t)layer * 256 * 64;
        const f32x4 pe4 = *((const f32x4*)(PE + kv * 256) + lane);
#pragma unroll
        for (int g = 0; g < 4; ++g) {
            const size_t R0 = (size_t)kv * 8192 + ((size_t)b * 256 + n) * 4 + g, R1 = R0 + 4;
            const f32x4 lo = *((const f32x4*)(LOHI + R0 * 512) + lane), hi = *((const f32x4*)(LOHI + R1 * 512 + 256) + lane);
            f32x4 h = lo + hi + pe4;
            h.x = pg8::fast_silu(h.x); h.y = pg8::fast_silu(h.y); h.z = pg8::fast_silu(h.z); h.w = pg8::fast_silu(h.w);
            *(LAS f32x4*)(hL + g * 256 + lane * 4) = h;
        }
        LDS_WAIT(); asm volatile("" ::: "memory");
        float acc[4] = {0.f, 0.f, 0.f, 0.f};
#pragma unroll 4
        for (int j4 = 0; j4 < 64; ++j4) {
            float wv[4];
#pragma unroll
            for (int e = 0; e < 4; ++e) wv[e] = (G == 256) ? W2L[(4 * j4 + e) * 64 + lane] : w2[(4 * j4 + e) * 64 + lane];
#pragma unroll
            for (int g = 0; g < 4; ++g) { const f32x4 hv = *(const LAS f32x4*)(hL + g * 256 + 4 * j4); acc[g] += hv.x * wv[0] + hv.y * wv[1] + hv.z * wv[2] + hv.w * wv[3]; }
        }
        LDS_WAIT(); asm volatile("" ::: "memory");
#pragma unroll
        for (int g = 0; g < 4; ++g) {
            const unsigned short o = (unsigned short)f2bf(acc[g]);
            if (kv == 0) { KC[((size_t)(b * 4 + g) * 256 + n) * 64 + lane] = o; if (n == 254) KC[((size_t)(b * 4 + g) * 256 + 255) * 64 + lane] = 0; }
            else { VCT[((size_t)(b * 4 + g) * 64 + lane) * 256 + n] = o; if (n == 254) VCT[((size_t)(b * 4 + g) * 64 + lane) * 256 + 255] = 0; }
        }
    }
    __syncthreads();
}
namespace att {
constexpr int KSTR = 128, TILE_B = 64 * KSTR;
constexpr int NBUF = 4, OFF_K = 0, OFF_V = NBUF * TILE_B, OFF_IMP = 2 * NBUF * TILE_B, OFF_SELM = OFF_IMP + 128 * 65 * 4, OFF_BUN = OFF_SELM + 1024, OFF_Q = OFF_BUN + 64;
constexpr float NEG = -1.0e30f, M0REF = -40.0f;
struct P { unsigned char* ws; f32x4* scr; };

#define MFMA16(a, b, c) __builtin_amdgcn_mfma_f32_16x16x32_bf16((a), (b), (c), 0, 0, 0)

__device__ __forceinline__ void qk_tile3(f32x4 (&st)[3][4], const LAS unsigned char* Kl, const LAS unsigned char* QL, int fr, int fq) {
    bf16x8 kf[4][2];
#pragma unroll
    for (int kt = 0; kt < 4; ++kt)
#pragma unroll
        for (int ks = 0; ks < 2; ++ks) kf[kt][ks] = *(const LAS bf16x8*)(Kl + (16 * kt + fr) * KSTR + (((4 * ks + fq) ^ (fr & 7)) << 4));
#pragma unroll
    for (int r = 0; r < 3; ++r)
#pragma unroll
        for (int kt = 0; kt < 4; ++kt) {
            f32x4 acc = {0.f, 0.f, 0.f, 0.f};
#pragma unroll
            for (int ks = 0; ks < 2; ++ks) acc = MFMA16(kf[kt][ks], *(const LAS bf16x8*)(QL + (r * 2 + ks) * 1024), acc);
            st[r][kt] = acc;
        }
}
__device__ __forceinline__ void qk_tile3_aug(f32x4 (&st)[3][4], const LAS unsigned char* Kl, const LAS unsigned char* QL, const unsigned (&qaw)[3], const unsigned (&kaw)[4], int fr, int fq) {
#pragma unroll
    for (int kt = 0; kt < 4; ++kt) {
        const LAS unsigned char* krow = Kl + (16 * kt + fr) * KSTR;
        const bf16x8 kf0 = *(const LAS bf16x8*)(krow + ((fq ^ (fr & 7)) << 4));
        const bf16x8 kf1 = *(const LAS bf16x8*)(krow + (((4 + fq) ^ (fr & 7)) << 4));
        const u32x4 ka = {kaw[kt], 0u, 0u, 0u};
#pragma unroll
        for (int r = 0; r < 3; ++r) {
            const u32x4 qa = {qaw[r], 0u, 0u, 0u};
            f32x4 acc = MFMA16(__builtin_bit_cast(bf16x8, ka), __builtin_bit_cast(bf16x8, qa), ((f32x4){0.f, 0.f, 0.f, 0.f}));
            acc = MFMA16(kf0, *(const LAS bf16x8*)(QL + (r * 2) * 1024), acc);
            st[r][kt] = MFMA16(kf1, *(const LAS bf16x8*)(QL + (r * 2 + 1) * 1024), acc);
        }
    }
}
__device__ __forceinline__ void pv_tile3(f32x4 (&o)[3][4], const LAS unsigned char* Vl, const f32x4 (&p)[3][4], int fr, int fq) {
    bf16x8 pb[3][2];
#pragma unroll
    for (int r = 0; r < 3; ++r)
#pragma unroll
        for (int kk = 0; kk < 2; ++kk) {
            u32x4 w; w.x = pk2(p[r][2 * kk][0], p[r][2 * kk][1]); w.y = pk2(p[r][2 * kk][2], p[r][2 * kk][3]); w.z = pk2(p[r][2 * kk + 1][0], p[r][2 * kk + 1][1]); w.w = pk2(p[r][2 * kk + 1][2], p[r][2 * kk + 1][3]);
            pb[r][kk] = __builtin_bit_cast(bf16x8, w);
        }
#pragma unroll
    for (int dt = 0; dt < 4; ++dt)
#pragma unroll
        for (int kk = 0; kk < 2; ++kk) {
            const LAS unsigned char* vrow = Vl + (16 * dt + fr) * KSTR + 8 * (fq & 1);
            const u32x2 v0 = *(const LAS u32x2*)(vrow + (((4 * kk + (fq >> 1)) ^ (fr & 7)) << 4)), v1 = *(const LAS u32x2*)(vrow + (((4 * kk + 2 + (fq >> 1)) ^ (fr & 7)) << 4));
            u32x4 w; w.x = v0.x; w.y = v0.y; w.z = v1.x; w.w = v1.y;
            const bf16x8 vf = __builtin_bit_cast(bf16x8, w);
#pragma unroll
            for (int r = 0; r < 3; ++r) o[r][dt] = MFMA16(vf, pb[r][kk], o[r][dt]);
        }
}
__device__ __forceinline__ float ex2(float x) { return __builtin_amdgcn_exp2f(x); }
__device__ __forceinline__ float rmax4(float a) {
    unsigned x = __builtin_bit_cast(unsigned, a);
    auto r1 = __builtin_amdgcn_permlane16_swap(x, x, false, false);
    unsigned u0 = r1[0], u1 = r1[1];
    asm volatile("" : "+v"(u0), "+v"(u1));
    a = fmaxf(__builtin_bit_cast(float, u0), __builtin_bit_cast(float, u1));
    x = __builtin_bit_cast(unsigned, a);
    auto r2 = __builtin_amdgcn_permlane32_swap(x, x, false, false);
    u0 = r2[0]; u1 = r2[1];
    asm volatile("" : "+v"(u0), "+v"(u1));
    return fmaxf(__builtin_bit_cast(float, u0), __builtin_bit_cast(float, u1));
}
__device__ __forceinline__ float max16(const f32x4 (&v)[4]) {
    float a = fmaxf(fmaxf(v[0][0], v[0][1]), fmaxf(v[0][2], v[0][3]));
#pragma unroll
    for (int kt = 1; kt < 4; ++kt) a = fmaxf(a, fmaxf(fmaxf(v[kt][0], v[kt][1]), fmaxf(v[kt][2], v[kt][3])));
    return rmax4(a);
}

__device__ __forceinline__ void qk_half(f32x4 (&st)[3][2], const LAS unsigned char* Kl, const LAS unsigned char* QL, const unsigned (&qaw)[3], const unsigned (&kaw)[4], int hf, const float (&cinit)[3], int fr, int fq) {
    const int sw = fr & 7;
#pragma unroll
    for (int k2 = 0; k2 < 2; ++k2) {
        const LAS unsigned char* krow = Kl + (32 * hf + 16 * k2 + fr) * KSTR;
        const bf16x8 kf0 = *(const LAS bf16x8*)(krow + ((fq ^ sw) << 4));
        const bf16x8 kf1 = *(const LAS bf16x8*)(krow + (((4 + fq) ^ sw) << 4));
        const u32x4 ka = {hf ? kaw[2 + k2] : kaw[k2], 0u, 0u, 0u};
#pragma unroll
        for (int r = 0; r < 3; ++r) {
            const u32x4 qa = {qaw[r], 0u, 0u, 0u};
            f32x4 acc = MFMA16(__builtin_bit_cast(bf16x8, ka), __builtin_bit_cast(bf16x8, qa), ((f32x4){cinit[r], cinit[r], cinit[r], cinit[r]}));
            acc = MFMA16(kf0, *(const LAS bf16x8*)(QL + (r * 2) * 1024), acc);
            st[r][k2] = MFMA16(kf1, *(const LAS bf16x8*)(QL + (r * 2 + 1) * 1024), acc);
        }
    }
}
__device__ __forceinline__ float max8(const f32x4 (&v)[2]) { return fmaxf(fmaxf(fmaxf(v[0][0], v[0][1]), fmaxf(v[0][2], v[0][3])), fmaxf(fmaxf(v[1][0], v[1][1]), fmaxf(v[1][2], v[1][3]))); }
template <int MODE>
__device__ __forceinline__ void flash_step(const LAS unsigned char* Kl, const LAS unsigned char* Vl, const LAS unsigned char* QL, const unsigned (&qaw)[3], const unsigned (&kaw)[4], const float (&sl2)[3],
                                           int rel, int dj, bool sel, bool need_mask, float (&m)[3], f32x4 (&O)[3][5], int fr, int fq) {
    constexpr float THR = 8.0f;
    const float djf = (float)dj;
    const int sw = fr & 7;
    float cmo[3];
#pragma unroll
    for (int r = 0; r < 3; ++r) cmo[r] = sl2[r] * djf - m[r];
#pragma unroll 1
    for (int hf = 0; hf < 2; ++hf) {
        f32x4 st[3][2];
        bf16x8 kfa[2], kfb[2];
#pragma unroll
        for (int k2 = 0; k2 < 2; ++k2) {
            const LAS unsigned char* krow = Kl + (32 * hf + 16 * k2 + fr) * KSTR;
            kfa[k2] = *(const LAS bf16x8*)(krow + ((fq ^ sw) << 4));
            kfb[k2] = *(const LAS bf16x8*)(krow + (((4 + fq) ^ sw) << 4));
        }
        __builtin_amdgcn_s_setprio(1);
#pragma unroll
        for (int r = 0; r < 3; ++r) {
            const u32x4 qa = {qaw[r], 0u, 0u, 0u};
#pragma unroll
            for (int k2 = 0; k2 < 2; ++k2) {
                const u32x4 ka = {hf ? kaw[2 + k2] : kaw[k2], 0u, 0u, 0u};
                f32x4 acc = MFMA16(__builtin_bit_cast(bf16x8, ka), __builtin_bit_cast(bf16x8, qa), ((f32x4){cmo[r], cmo[r], cmo[r], cmo[r]}));
                acc = MFMA16(kfa[k2], *(const LAS bf16x8*)(QL + (r * 2) * 1024), acc);
                st[r][k2] = MFMA16(kfb[k2], *(const LAS bf16x8*)(QL + (r * 2 + 1) * 1024), acc);
            }
        }
        __builtin_amdgcn_s_setprio(0);
        if (need_mask) {
#pragma unroll
            for (int k2 = 0; k2 < 2; ++k2)
#pragma unroll
                for (int e = 0; e < 4; ++e) {
                    const int pr = rel + 32 * hf + 16 * k2 + e;
                    bool ok = pr <= 0;
                    if (MODE == 0) ok = ok && sel; else ok = ok && (pr > -512);
#pragma unroll
                    for (int r = 0; r < 3; ++r) st[r][k2][e] = ok ? st[r][k2][e] : NEG;
                }
        }
        float a[3];
#pragma unroll
        for (int r = 0; r < 3; ++r) a[r] = fmaxf(fmaxf(fmaxf(st[r][0][0], st[r][0][1]), fmaxf(st[r][0][2], st[r][0][3])), fmaxf(fmaxf(st[r][1][0], st[r][1][1]), fmaxf(st[r][1][2], st[r][1][3])));
        if (__any(fmaxf(fmaxf(a[0], a[1]), a[2]) > THR)) {
#pragma unroll
            for (int r = 0; r < 3; ++r) {
                const float mx = rmax4(a[r]);
                const float delta = mx > THR ? mx : 0.f;
                m[r] += delta; cmo[r] -= delta;
                const float alpha = ex2(-delta);
#pragma unroll
                for (int dt = 0; dt < 5; ++dt) O[r][dt] = O[r][dt] * alpha;
#pragma unroll
                for (int k2 = 0; k2 < 2; ++k2) st[r][k2] = st[r][k2] - delta;
            }
        }
        bf16x8 vf[4];
#pragma unroll
        for (int dt = 0; dt < 4; ++dt) {
            const LAS unsigned char* vrow = Vl + (16 * dt + fr) * KSTR + 8 * (fq & 1);
            const u32x2 v0 = *(const LAS u32x2*)(vrow + (((4 * hf + (fq >> 1)) ^ sw) << 4)), v1 = *(const LAS u32x2*)(vrow + (((4 * hf + 2 + (fq >> 1)) ^ sw) << 4));
            u32x4 w; w.x = v0.x; w.y = v0.y; w.z = v1.x; w.w = v1.y;
            vf[dt] = __builtin_bit_cast(bf16x8, w);
        }
        const unsigned one2 = (fr == 0) ? 0x3f803f80u : 0u;
        const u32x4 w1 = {one2, one2, one2, one2};
        const bf16x8 vone = __builtin_bit_cast(bf16x8, w1);
#pragma unroll
        for (int r = 0; r < 3; ++r) {
#pragma unroll
            for (int k2 = 0; k2 < 2; ++k2)
#pragma unroll
                for (int e = 0; e < 4; ++e) st[r][k2][e] = ex2(st[r][k2][e]);
            u32x4 w; w.x = pk2(st[r][0][0], st[r][0][1]); w.y = pk2(st[r][0][2], st[r][0][3]); w.z = pk2(st[r][1][0], st[r][1][1]); w.w = pk2(st[r][1][2], st[r][1][3]);
            const bf16x8 pb = __builtin_bit_cast(bf16x8, w);
#pragma unroll
            for (int dt = 0; dt < 4; ++dt) O[r][dt] = MFMA16(vf[dt], pb, O[r][dt]);
            O[r][4] = MFMA16(vone, pb, O[r][4]);
        }
    }
}

#define ATT_DMA(buf, kp, vp, vstride) do { \
    __builtin_amdgcn_global_load_lds((const unsigned*)((kp) + lrow * 64 + lchs * 8), (LAS unsigned*)(lds + OFF_K + (buf) * TILE_B + w * 1024), 16, 0, 0); \
    __builtin_amdgcn_global_load_lds((const unsigned*)((vp) + (size_t)lrow * (vstride) + lchs * 8), (LAS unsigned*)(lds + OFF_V + (buf) * TILE_B + w * 1024), 16, 0, 0); } while (0)
#define ATT_WAIT_SYNC() do { asm volatile("s_waitcnt vmcnt(0) lgkmcnt(0)\n\ts_barrier" ::: "memory"); } while (0)
#define ATT_WAIT_SYNC2(more) do { if (more) asm volatile("s_waitcnt vmcnt(2) lgkmcnt(0)\n\ts_barrier" ::: "memory"); else asm volatile("s_waitcnt vmcnt(0) lgkmcnt(0)\n\ts_barrier" ::: "memory"); } while (0)
#define ATT_POP(rem_, j_) do { j_ = 63 - __builtin_clzll(rem_); rem_ &= ~(1ull << j_); } while (0)

__device__ __forceinline__ void attn_item(LAS unsigned char* lds, const P& p, int b, int g, int I) {
    const int tid = my_tid(), lane = tid & 63, w = __builtin_amdgcn_readfirstlane(tid >> 6), fr = lane & 15, fq = lane >> 4;
    const int tq = 128 * I + 16 * w + fr;
    const int iq = 2 * I + (w >> 2);
    const size_t row = (size_t)b * T + tq;
    const int bg = b * 4 + g;
    const int lrow = tid >> 3, lchs = (tid & 7) ^ (lrow & 7);
    LAS float* IMP = (LAS float*)(lds + OFF_IMP);
    LAS unsigned* SELM = (LAS unsigned*)(lds + OFF_SELM);
    LAS unsigned* BUN = (LAS unsigned*)(lds + OFF_BUN);
    for (int i = tid; i < 128 * 65; i += 512) IMP[i] = 0.f;
    if (tid < 2) BUN[tid] = 0u;
    LAS unsigned char* QL = lds + OFF_Q + w * 6144 + lane * 16;
    float sl2[3];
#pragma unroll
    for (int r = 0; r < 3; ++r) {
        const int h = 3 * g + r;
        sl2[r] = (h < 8 ? exp2f(-(float)(h + 1)) : exp2f(-(0.5f + (float)(h - 8)))) * LOG2E;
#pragma unroll
        for (int ks = 0; ks < 2; ++ks) *(LAS bf16x8*)(QL + (r * 2 + ks) * 1024) = *(const bf16x8*)((const bf16*)(p.ws + WS_Q) + row * 768 + h * 64 + 32 * ks + 8 * fq);
    }
    LAS float* gp = (LAS float*)(lds + OFF_Q + 49152) + (16 * w + fr) * 12;
    if (fq < 3) { const float* gsrc = (const float*)(p.ws + WS_G) + row * 36 + 9 * g + 3 * fq; const float g0 = gsrc[0], g1 = gsrc[1], g2 = gsrc[2]; gp[3 * fq] = g0; gp[3 * fq + 1] = g1; gp[3 * fq + 2] = g2; }
    unsigned qaw[3], kaw[4];
#pragma unroll
    for (int r = 0; r < 3; ++r) { const unsigned hi = f2bf(sl2[r]); const unsigned lo = f2bf(sl2[r] - __builtin_bit_cast(float, hi << 16)); qaw[r] = (fq == 0) ? (hi | (lo << 16)) : 0u; }
#pragma unroll
    for (int kt = 0; kt < 4; ++kt) { const unsigned c = f2bf((float)(16 * kt + fr)); kaw[kt] = (fq == 0) ? (c | (c << 16)) : 0u; }
    unsigned qaw16[3];
#pragma unroll
    for (int r = 0; r < 3; ++r) { const float x = 16.0f * sl2[r]; const unsigned hi = f2bf(x); const unsigned lo = f2bf(x - __builtin_bit_cast(float, hi << 16)); qaw16[r] = (fq == 0) ? (hi | (lo << 16)) : 0u; }
    const int tqmin = 128 * I + 16 * w;
    const bf16* KCp = (const bf16*)(p.ws + WS_KC) + (size_t)bg * 256 * 64; const bf16* VCp = (const bf16*)(p.ws + WS_VCT) + (size_t)bg * 64 * 256;
    const int nT = (8 * I + 7 + 63) >> 6;
    const int tqmax = 128 * I + 16 * w + 15;
    float m[3], l[3];
#pragma unroll
    for (int r = 0; r < 3; ++r) { m[r] = M0REF; l[r] = 0.f; }
    for (int t = 0; t < nT; ++t) ATT_DMA(t, KCp + t * 64 * 64, VCp + t * 64, 256);
    ATT_WAIT_SYNC();
    for (int Tt = 0; Tt < nT; ++Tt) {
        if (1024 * Tt + 31 <= tqmax) {
            const LAS unsigned char* Kl = lds + OFF_K + Tt * TILE_B;
            const int crel = 16 * (64 * Tt + 4 * fq) - tq;
            const bool full = 16 * (64 * Tt + 63) + 31 <= tqmin;
            const float cb = (float)(1024 * Tt - tq) + 15.5f;
            float cmo[3];
#pragma unroll
            for (int r = 0; r < 3; ++r) cmo[r] = sl2[r] * cb - m[r];
#pragma unroll 1
            for (int hf = 0; hf < 2; ++hf) {
                f32x4 st[3][2]; qk_half(st, Kl, QL, qaw16, kaw, hf, cmo, fr, fq);
                if (!full) {
#pragma unroll
                    for (int k2 = 0; k2 < 2; ++k2)
#pragma unroll
                        for (int e = 0; e < 4; ++e) { const bool ok = crel + 512 * hf + 256 * k2 + 16 * e + 31 <= 0;
#pragma unroll
                            for (int r = 0; r < 3; ++r) st[r][k2][e] = ok ? st[r][k2][e] : NEG; }
                }
                float a[3];
#pragma unroll
                for (int r = 0; r < 3; ++r) a[r] = max8(st[r]);
                if (__any(fmaxf(fmaxf(a[0], a[1]), a[2]) > 6.0f)) {
#pragma unroll
                    for (int r = 0; r < 3; ++r) {
                        const float mx = rmax4(a[r]);
                        const float delta = mx > 6.0f ? mx : 0.f;
                        m[r] += delta; cmo[r] -= delta; l[r] *= ex2(-delta);
#pragma unroll
                        for (int k2 = 0; k2 < 2; ++k2) st[r][k2] = st[r][k2] - delta;
                    }
                }
#pragma unroll
                for (int r = 0; r < 3; ++r) {
                    float ps = 0.f;
#pragma unroll
                    for (int k2 = 0; k2 < 2; ++k2)
#pragma unroll
                        for (int e = 0; e < 4; ++e) ps += ex2(st[r][k2][e]);
                    l[r] += ps;
                }
            }
        }
    }
    float invl[3];
#pragma unroll
    for (int r = 0; r < 3; ++r) { float s = l[r]; s += __shfl_xor(s, 16); s += __shfl_xor(s, 32); invl[r] = s > 0.f ? -(m[r] + __builtin_amdgcn_logf(s)) : NEG; }
    __syncthreads();
    f32x4 O[3][4];
#pragma unroll
    for (int r = 0; r < 3; ++r)
#pragma unroll
        for (int dt = 0; dt < 4; ++dt) O[r][dt] = (f32x4){0.f, 0.f, 0.f, 0.f};
    for (int Tt = 0; Tt < nT; ++Tt) {
        if (1024 * Tt + 31 <= tqmax) {
            const LAS unsigned char* Kl = lds + OFF_K + Tt * TILE_B; const LAS unsigned char* Vl = lds + OFF_V + Tt * TILE_B;
            const int crel = 16 * (64 * Tt + 4 * fq) - tq;
            const bool full = 16 * (64 * Tt + 63) + 31 <= tqmin;
            const float cb = (float)(1024 * Tt - tq) + 15.5f;
            const int sw = fr & 7;
            float cfin[3];
#pragma unroll
            for (int r = 0; r < 3; ++r) cfin[r] = sl2[r] * cb + invl[r];
#pragma unroll 1
            for (int hf = 0; hf < 2; ++hf) {
                f32x4 st[3][2]; qk_half(st, Kl, QL, qaw16, kaw, hf, cfin, fr, fq);
                float ia[2] = {0.f, 0.f}, ib[2] = {0.f, 0.f};
                bf16x8 vf[4];
#pragma unroll
                for (int dt = 0; dt < 4; ++dt) {
                    const LAS unsigned char* vrow = Vl + (16 * dt + fr) * KSTR + 8 * (fq & 1);
                    const u32x2 v0 = *(const LAS u32x2*)(vrow + (((4 * hf + (fq >> 1)) ^ sw) << 4)), v1 = *(const LAS u32x2*)(vrow + (((4 * hf + 2 + (fq >> 1)) ^ sw) << 4));
                    u32x4 w; w.x = v0.x; w.y = v0.y; w.z = v1.x; w.w = v1.y;
                    vf[dt] = __builtin_bit_cast(bf16x8, w);
                }
#pragma unroll
                for (int r = 0; r < 3; ++r) {
#pragma unroll
                    for (int k2 = 0; k2 < 2; ++k2) {
                        if (full) {
#pragma unroll
                            for (int e = 0; e < 4; ++e) st[r][k2][e] = ex2(st[r][k2][e]);
                        } else {
#pragma unroll
                            for (int e = 0; e < 4; ++e) st[r][k2][e] = (crel + 512 * hf + 256 * k2 + 16 * e + 31 <= 0) ? ex2(st[r][k2][e]) : 0.f;
                        }
                        ia[k2] += (st[r][k2][0] + st[r][k2][1]) + (st[r][k2][2] + st[r][k2][3]); ib[k2] += st[r][k2][3];
                    }
                    u32x4 w; w.x = pk2(st[r][0][0], st[r][0][1]); w.y = pk2(st[r][0][2], st[r][0][3]); w.z = pk2(st[r][1][0], st[r][1][1]); w.w = pk2(st[r][1][2], st[r][1][3]);
                    const bf16x8 pb = __builtin_bit_cast(bf16x8, w);
#pragma unroll
                    for (int dt = 0; dt < 4; ++dt) O[r][dt] = MFMA16(vf[dt], pb, O[r][dt]);
                }
                LAS float* ip = IMP + (16 * w + fr) * 65 + 16 * Tt + 8 * hf + fq;
#pragma unroll
                for (int k2 = 0; k2 < 2; ++k2) {
                    __hip_atomic_fetch_add(ip + 4 * k2, ia[k2], __ATOMIC_RELAXED, __HIP_MEMORY_SCOPE_WORKGROUP);
                    if (16 * Tt + 8 * hf + 4 * k2 + fq + 1 < 64) __hip_atomic_fetch_add(ip + 4 * k2 + 1, ib[k2], __ATOMIC_RELAXED, __HIP_MEMORY_SCOPE_WORKGROUP);
                }
            }
        }
    }
#pragma unroll
    for (int r = 0; r < 3; ++r) { const float gc = gp[3 * r + 0];
#pragma unroll
        for (int dt = 0; dt < 4; ++dt) p.scr[(r * 4 + dt) * 512] = O[r][dt] * gc; }
    __syncthreads();
    {
        const int tok = tid >> 2, qd = tid & 3, cur = iq;
        unsigned long long mask;
        if (cur < 8) mask = (2ull << cur) - 1ull;
        else {
            mask = 1ull | (1ull << cur) | (1ull << (cur - 1));
            float v[16];
#pragma unroll
            for (int jj = 0; jj < 16; ++jj) { const int j = 16 * qd + jj; const float x = IMP[tok * 65 + j]; v[jj] = (j <= cur && j != 0 && j != cur && j != cur - 1) ? x : -1.0f; }
#pragma unroll 1
            for (int rd = 0; rd < 5; ++rd) {
                float bv = v[0]; int bj = 16 * qd;
#pragma unroll
                for (int jj = 1; jj < 16; ++jj) if (v[jj] > bv) { bv = v[jj]; bj = 16 * qd + jj; }
#pragma unroll
                for (int o = 1; o <= 2; o <<= 1) {
                    const int bvb = __builtin_bit_cast(int, bv);
                    const float ov = __builtin_bit_cast(float, o == 1 ? __builtin_amdgcn_update_dpp(bvb, bvb, 0xB1, 0xF, 0xF, true) : __builtin_amdgcn_update_dpp(bvb, bvb, 0x4E, 0xF, 0xF, true));
                    const int oj = o == 1 ? __builtin_amdgcn_update_dpp(bj, bj, 0xB1, 0xF, 0xF, true) : __builtin_amdgcn_update_dpp(bj, bj, 0x4E, 0xF, 0xF, true);
                    if (ov > bv || (ov == bv && oj < bj)) { bv = ov; bj = oj; } }
                if (bv >= 0.f) mask |= 1ull << bj;
#pragma unroll
                for (int jj = 0; jj < 16; ++jj) if (16 * qd + jj == bj) v[jj] = -1.0f;
            }
        }
        if (qd == 0) { SELM[tok * 2] = (unsigned)mask; SELM[tok * 2 + 1] = (unsigned)(mask >> 32); }
    }
    __syncthreads();
    const unsigned selLo = SELM[(16 * w + fr) * 2], selHi = SELM[(16 * w + fr) * 2 + 1];
    unsigned wlo = selLo, whi = selHi;
#pragma unroll
    for (int o = 1; o <= 8; o <<= 1) { wlo |= __shfl_xor(wlo, o); whi |= __shfl_xor(whi, o); }
    wlo = __builtin_amdgcn_readfirstlane(wlo); whi = __builtin_amdgcn_readfirstlane(whi);
    if (lane == 0) { __hip_atomic_fetch_or(BUN, wlo, __ATOMIC_RELAXED, __HIP_MEMORY_SCOPE_WORKGROUP); __hip_atomic_fetch_or(BUN + 1, whi, __ATOMIC_RELAXED, __HIP_MEMORY_SCOPE_WORKGROUP); }
    __syncthreads();
    const unsigned long long bun = (unsigned long long)__builtin_amdgcn_readfirstlane(BUN[0]) | ((unsigned long long)__builtin_amdgcn_readfirstlane(BUN[1]) << 32);
    const unsigned long long wun = (unsigned long long)wlo | ((unsigned long long)whi << 32);
    const unsigned long long selm = (unsigned long long)selLo | ((unsigned long long)selHi << 32);
    f32x4 O5[3][5];
    {
        const bf16* Kp = (const bf16*)(p.ws + WS_KS) + (size_t)bg * T * 64; const bf16* Vp = (const bf16*)(p.ws + WS_VST) + (size_t)bg * 64 * T;
#pragma unroll
        for (int r = 0; r < 3; ++r) { m[r] = M0REF;
#pragma unroll
            for (int dt = 0; dt < 5; ++dt) O5[r][dt] = (f32x4){0.f, 0.f, 0.f, 0.f}; }
        unsigned long long rem = bun; int cur = 0, ja, jb = -1;
        asm volatile("s_waitcnt vmcnt(0)" ::: "memory");
        ATT_POP(rem, ja); ATT_DMA(0, Kp + (size_t)ja * 64 * 64, Vp + ja * 64, T);
        if (rem) { ATT_POP(rem, jb); ATT_DMA(1, Kp + (size_t)jb * 64 * 64, Vp + jb * 64, T); }
        while (ja >= 0) {
            ATT_WAIT_SYNC();
            int na = -1, nb = -1;
            if (rem) { ATT_POP(rem, na); ATT_DMA(cur ^ 2, Kp + (size_t)na * 64 * 64, Vp + na * 64, T); }
            if (rem) { ATT_POP(rem, nb); ATT_DMA((cur ^ 2) + 1, Kp + (size_t)nb * 64 * 64, Vp + nb * 64, T); }
            if ((wun >> ja) & 1ull) {
                const bool selb = ((selm >> ja) & 1ull) != 0ull;
                const bool nm = (ja == iq) || !__all(selb);
                flash_step<0>(lds + OFF_K + cur * TILE_B, lds + OFF_V + cur * TILE_B, QL, qaw, kaw, sl2, 64 * ja + 4 * fq - tq, 64 * ja - tq, selb, nm, m, O5, fr, fq);
            }
            if (jb >= 0 && ((wun >> jb) & 1ull)) {
                const bool selb = ((selm >> jb) & 1ull) != 0ull;
                const bool nm = (jb == iq) || !__all(selb);
                flash_step<0>(lds + OFF_K + (cur + 1) * TILE_B, lds + OFF_V + (cur + 1) * TILE_B, QL, qaw, kaw, sl2, 64 * jb + 4 * fq - tq, 64 * jb - tq, selb, nm, m, O5, fr, fq);
            }
            ja = na; jb = nb; cur ^= 2;
        }
#pragma unroll
        for (int r = 0; r < 3; ++r) { const float s = __shfl(O5[r][4][0], fr); const float sc = gp[3 * r + 1] / s;
#pragma unroll
            for (int dt = 0; dt < 4; ++dt) p.scr[(12 + r * 4 + dt) * 512] = O5[r][dt] * sc; }
    }
    __syncthreads();
    {
        const bf16* Kp = (const bf16*)(p.ws + WS_KW) + (size_t)bg * T * 64; const bf16* Vp = (const bf16*)(p.ws + WS_VWT) + (size_t)bg * 64 * T;
#pragma unroll
        for (int r = 0; r < 3; ++r) { m[r] = M0REF;
#pragma unroll
            for (int dt = 0; dt < 5; ++dt) O5[r][dt] = (f32x4){0.f, 0.f, 0.f, 0.f}; }
        const int jlo = (2 * I - 8) > 0 ? (2 * I - 8) : 0, jhi = 2 * I + 1;
        asm volatile("s_waitcnt vmcnt(0)" ::: "memory");
        ATT_DMA(0, Kp + (size_t)jhi * 64 * 64, Vp + jhi * 64, T);
        if (jhi - 1 >= jlo) ATT_DMA(1, Kp + (size_t)(jhi - 1) * 64 * 64, Vp + (jhi - 1) * 64, T);
        int cur = 0;
        for (int j = jhi; j >= jlo; j -= 2) {
            ATT_WAIT_SYNC();
            if (j - 2 >= jlo) ATT_DMA(cur ^ 2, Kp + (size_t)(j - 2) * 64 * 64, Vp + (j - 2) * 64, T);
            if (j - 3 >= jlo) ATT_DMA((cur ^ 2) + 1, Kp + (size_t)(j - 3) * 64 * 64, Vp + (j - 3) * 64, T);
            if (j >= iq - 8 && j <= iq)
                flash_step<1>(lds + OFF_K + cur * TILE_B, lds + OFF_V + cur * TILE_B, QL, qaw, kaw, sl2, 64 * j + 4 * fq - tq, 64 * j - tq, true, (j == iq) || (j == iq - 8), m, O5, fr, fq);
            const int jj = j - 1;
            if (jj >= jlo && jj >= iq - 8 && jj <= iq)
                flash_step<1>(lds + OFF_K + (cur + 1) * TILE_B, lds + OFF_V + (cur + 1) * TILE_B, QL, qaw, kaw, sl2, 64 * jj + 4 * fq - tq, 64 * jj - tq, true, (jj == iq) || (jj == iq - 8), m, O5, fr, fq);
            cur ^= 2;
        }
#pragma unroll
        for (int r = 0; r < 3; ++r) { const float s = __shfl(O5[r][4][0], fr); const float sc = gp[3 * r + 2] / s;
#pragma unroll
            for (int dt = 0; dt < 4; ++dt) {
                const f32x4 v = (p.scr[(r * 4 + dt) * 512] + p.scr[(12 + r * 4 + dt) * 512]) + O5[r][dt] * sc;
                *(unsigned long long*)((bf16*)(p.ws + WS_XN) + row * D + 256 + (3 * g + r) * 64 + 16 * dt + 4 * fq) = (unsigned long long)pk2(v[0], v[1]) | ((unsigned long long)pk2(v[2], v[3]) << 32);
            } }
    }
    __syncthreads();
}

__device__ __forceinline__ void attn_phase(LAS unsigned char* lds, const P& p, int blk, int G) {
    for (int L = blk; L < 1024; L += G) {
        int bg, I;
        if (G == 256) {
            const int v = L & 255, i = L >> 8, c = v >> 3, s = c & 7, q = c >> 3, ii = (i + q) & 3;
            bg = (v & 7) * 4 + i; I = (ii == 0) ? s : (ii == 1) ? 15 - s : (ii == 2) ? 16 + s : 31 - s; }
        else { bg = L >> 5; I = L & 31; }
        attn_item(lds, p, bg >> 2, bg & 3, I);
    }
}
}
#define XB_TMO      128
#define XB_XCNT(j)  (256  + 64 * (j))
#define XB_XSUB(j)  (1280 + 64 * (j))
#define XB_XGEN(j)  (2304 + 64 * (j))
#define XB_TOP      3328
#define XB_TOPGEN   3392
#define XCD_BAR_WORDS 3456
#define XB_SPIN_CAP (1u << 18)

__device__ __forceinline__ unsigned xb_ld(unsigned* p)              { return __hip_atomic_load(p, __ATOMIC_RELAXED, __HIP_MEMORY_SCOPE_AGENT); }
__device__ __forceinline__ unsigned xb_add(unsigned* p, unsigned v) { return __hip_atomic_fetch_add(p, v, __ATOMIC_RELAXED, __HIP_MEMORY_SCOPE_AGENT); }
__device__ __forceinline__ unsigned xb_xcc_id() { return (unsigned)__builtin_amdgcn_s_getreg((3 << 11) | 20) & 0xFu; }
#define XB_SPIN(cond, bar) do { unsigned _sp = 0; while (cond) { __builtin_amdgcn_s_sleep(1); \
    if ((++_sp & 255u) == 0u) { if (xb_ld(&(bar)[XB_TMO])) break; if (_sp > XB_SPIN_CAP) { atomicAdd(&(bar)[XB_TMO], 1u); break; } } } } while (0)

struct XcdBarrier {
    unsigned* bar; unsigned x;
    volatile LAS unsigned* st;
};

__device__ __forceinline__ XcdBarrier xcd_barrier_post(unsigned* bar, volatile LAS unsigned* st) {
    XcdBarrier b; b.bar = bar; b.x = xb_xcc_id(); b.st = st;
    if (threadIdx.x == 0) (void)xb_add(&bar[XB_XCNT(b.x)], 1u);
    return b;
}
__device__ __forceinline__ void xcd_barrier_complete(unsigned* bar, unsigned x, unsigned& nloc, unsigned& nx) {
    const unsigned G = gridDim.x * gridDim.y * gridDim.z;
    unsigned sum, cnt, mine, sp = 0u;
    for (;;) {
        sum = 0u; cnt = 0u; mine = 0u;
#pragma unroll
        for (unsigned j = 0; j < 16; ++j) { const unsigned c = xb_ld(&bar[XB_XCNT(j)]); sum += c; cnt += (c > 0u) ? 1u : 0u; mine = (j == x) ? c : mine; }
        if (sum == G) break;
        __builtin_amdgcn_s_sleep(1);
        if ((++sp & 255u) == 0u) { if (xb_ld(&bar[XB_TMO])) break; if (sp > XB_SPIN_CAP) { atomicAdd(&bar[XB_TMO], 1u); break; } }
    }
    nloc = mine > 0u ? mine : 1u; nx = cnt > 0u ? cnt : 1u;
}

__device__ __forceinline__ void xcd_barrier(const XcdBarrier& b) {
    asm volatile("s_waitcnt vmcnt(0)" ::: "memory");
    __syncthreads();
    if (threadIdx.x == 0) {
        unsigned* bar = b.bar;
        __builtin_amdgcn_s_waitcnt(0);
        unsigned nloc = b.st[0], nx = b.st[1];
        if (nloc == 0u) { xcd_barrier_complete(bar, b.x, nloc, nx); b.st[0] = nloc; b.st[1] = nx; }
        const unsigned old = xb_add(&bar[XB_XSUB(b.x)], 1u);
        const unsigned gen = old / nloc;
        if (old + 1u == (gen + 1u) * nloc) {
            __builtin_amdgcn_fence(__ATOMIC_RELEASE, "agent");
            asm volatile("s_waitcnt vmcnt(0)" ::: "memory");
            const unsigned og = xb_add(&bar[XB_TOP], 1u);
            const unsigned tg = og / nx;
            if (og + 1u == (tg + 1u) * nx) xb_add(&bar[XB_TOPGEN], 1u);
            else XB_SPIN(xb_ld(&bar[XB_TOPGEN]) == tg, bar);
            __builtin_amdgcn_fence(__ATOMIC_ACQUIRE, "agent");
            xb_add(&bar[XB_XGEN(b.x)], 1u);
            asm volatile("s_waitcnt vmcnt(0)" ::: "memory");
        } else {
            XB_SPIN(xb_ld(&bar[XB_XGEN(b.x)]) == gen, bar);
            __builtin_amdgcn_fence(__ATOMIC_ACQUIRE, "agent");
            asm volatile("s_waitcnt vmcnt(0)" ::: "memory");
        }
    }
    __syncthreads();
}

__global__ void __launch_bounds__(512, 2) hymba_fwd(Args args) {
    extern __shared__ __attribute__((aligned(16))) unsigned char lds_raw[];
    LAS unsigned char* lds = (LAS unsigned char*)lds_raw;
    cg::grid_group grid = cg::this_grid();
    const int G = gridDim.x;
    {
        LAS unsigned long long* ptw = (LAS unsigned long long*)(lds + MISC_OFF + 64);
        if (threadIdx.x == 0) {
#pragma unroll
            for (int i = 0; i < 18; ++i) ptw[i] = (unsigned long long)args.in[i];
            ptw[18] = (unsigned long long)args.out; ptw[19] = (unsigned long long)args.ws;
        }
    }
    const int ph_lo = args.ph_lo, ph_hi = args.ph_hi;
    if (threadIdx.x < 8) ((LAS unsigned*)(lds + MISC_OFF))[threadIdx.x] = 0u;
    __syncthreads();
    XcdBarrier xbar = xcd_barrier_post((unsigned*)(args.ws + WS_CTL), (volatile LAS unsigned*)(lds + MISC_OFF));
    bool first_sync = (ph_lo < 0);
#ifndef USE_CG_SYNC
#define USE_CG_SYNC 0
#endif
#ifndef PROBE_DUP_MASK
#define PROBE_DUP_MASK 0
#endif
#ifndef PROBE_DUP_SYNC
#define PROBE_DUP_SYNC 0
#endif
    for (int ph2 = ph_lo * 2; ph2 < ph_hi * 2; ++ph2) {
        const int ph = ph2 >> 1;
        const int layer = ph / NPH, k = ph % NPH;
        if ((ph2 & 1) && !((PROBE_DUP_MASK >> k & 1) && ph != DEPTH * NPH)) continue;
        int blk = blockIdx.x; asm volatile("" : "+s"(blk));
        PT a; a.t = (LAS const unsigned long long*)(lds + MISC_OFF + 64); a.ap = &args; a.ws = (unsigned char*)a.raw(19);
        unsigned char* ws = a.ws; float* X = (float*)(ws + WS_X); bf16* XN = (bf16*)(ws + WS_XN);
        const float* xin = layer == 0 ? a.in(0) : X;
        unsigned char* wset = ws + WS_WSET + (size_t)(layer & 1) * WSET_BYTES;
        bf16* XB = (bf16*)(ws + WS_XB); float* RSQ1 = (float*)(ws + WS_RSQ); float* RSQ2 = RSQ1 + (size_t)M * 16;
        if (ph != DEPTH * NPH && ((k == 0 && layer > 0) || k == 8)) continue;
        if (ph == DEPTH * NPH) {
            final_rows(XB, RSQ1, a.in(17), (float*)a.raw(18), blk, G);
        } else if (k == 0) {
            prologue_layer(a, 0, lds, blk, G);
            first_rows(xin, XB, RSQ1, blk, G);
        } else if (k == 1) {
            pg8::Gemm g{XB, (const bf16*)(wset + OFF_WIN), M, 2560, D}; pg8::StaticOrder S; S.init(M, 2560, G, blk);
            LAS float* RS = (LAS float*)(lds + 131072); pg8::prep_rstd(S, RSQ1, RS, my_tid());
            pg8::EpiWin E{(bf16*)(ws + WS_ACONV), (bf16*)(ws + WS_Q), (bf16*)(ws + WS_KCR), (bf16*)(ws + WS_VCR), (bf16*)(ws + WS_KS), (bf16*)(ws + WS_KW), (float*)(ws + WS_G), RS};
            pg8::gemm_phase<pg8::EpiWin, pg8::StaticOrder, true, true, false>(lds, g, S, E);
        } else if (k == 2) {
            pg8::Gemm g{XB, (const bf16*)(wset + OFF_WIN) + (size_t)2560 * D, M, 512, D}; pg8::StaticOrder S; S.init(M, 512, G, blk);
            LAS float* RS = (LAS float*)(lds + 131072); pg8::prep_rstd(S, RSQ1, RS, my_tid());
            pg8::EpiVT E{(bf16*)(ws + WS_VST), (bf16*)(ws + WS_VWT), RS};
            pg8::gemm_phase<pg8::EpiVT, pg8::StaticOrder, true, true, true>(lds, g, S, E);
        } else if (k == 3) {
            pg8::Gemm g{(const bf16*)(ws + WS_KCR), (const bf16*)(wset + OFF_CMPW), 16384, 1024, D}; pg8::CmpOrder S{G, blk};
            pg8::EpiCmp E{(float*)(ws + WS_LOHI)};
            pg8::gemm_phase<pg8::EpiCmp, pg8::CmpOrder, true, true, false>(lds, g, S, E);
        } else if (k == 4) {
            conv_phase(a, layer, lds, blk, G);
        } else if (k == 5) {
            cmp2_phase(a, layer, lds, blk, G);
            if (layer + 1 < DEPTH) { __syncthreads(); prologue_layer(a, layer + 1, lds, blk, G); }
        } else if (k == 6) {
            att::P p{ws, (f32x4*)(ws + WS_ASCR) + (size_t)blk * (24 * 512) + my_tid()};
            att::attn_phase(lds, p, blk, G);
        } else if (k == 7) {
            pg8::Gemm g{XN, (const bf16*)(wset + OFF_WOUT), M, D, D}; pg8::StaticOrder S; S.init(M, D, G, blk);
            pg8::EpiRes E{XB, RSQ2};
            pg8::gemm_phase<pg8::EpiRes, pg8::StaticOrder, true, true, false>(lds, g, S, E);
        } else if (k == 9) {
            pg8::Gemm g{XB, (const bf16*)(wset + OFF_WGU), M, 2 * DFF, D}; pg8::StaticOrder S; S.init(M, 2 * DFF, G, blk);
            LAS float* RS = (LAS float*)(lds + 131072); pg8::prep_rstd(S, RSQ2, RS, my_tid());
            pg8::EpiSwiglu E{(bf16*)(ws + WS_HFF), RS};
            pg8::gemm_phase<pg8::EpiSwiglu, pg8::StaticOrder, true, true, false>(lds, g, S, E);
        } else {
            pg8::Gemm g{(const bf16*)(ws + WS_HFF), (const bf16*)(wset + OFF_WD), M, D, DFF}; pg8::StaticOrder S; S.init(M, D, G, blk);
            pg8::EpiRes E{XB, RSQ1};
            pg8::gemm_phase<pg8::EpiRes, pg8::StaticOrder, true, true, false>(lds, g, S, E);
        }
        if (ph2 + 1 < ph_hi * 2) { if ((k == 1 || k == 3) && !(PROBE_DUP_MASK >> k & 1)) __syncthreads(); else { if (first_sync || USE_CG_SYNC) { grid.sync(); first_sync = false; } else xcd_barrier(xbar); if (PROBE_DUP_SYNC) xcd_barrier(xbar); } }
    }
}

#ifndef MULTI_LAUNCH
#define MULTI_LAUNCH 0
#endif
extern "C" void kernel_launch(void* const* d_in, const int* in_sizes, int n_in, void* d_out, int out_size, void* d_ws, size_t ws_size, hipStream_t stream) {
    static int grid = 0;
    if (grid == 0) {
        if (n_in != 18 || out_size != M * D || ws_size < WS_END) { fprintf(stderr, "kernel_launch: unexpected shapes: n_in %d out %d ws %zu (need %zu)\n", n_in, out_size, ws_size, (size_t)WS_END); grid = -1; return; }
        int dev = 0, cus = 0, per_cu = 0;
        (void)hipGetDevice(&dev);
        (void)hipDeviceGetAttribute(&cus, hipDeviceAttributeMultiprocessorCount, dev);
        (void)hipFuncSetAttribute((const void*)hymba_fwd, hipFuncAttributeMaxDynamicSharedMemorySize, LDS_BYTES);
        (void)hipOccupancyMaxActiveBlocksPerMultiprocessor(&per_cu, (const void*)hymba_fwd, 512, LDS_BYTES);
        fprintf(stderr, "kernel_launch: cus %d per_cu %d ws %zu\n", cus, per_cu, ws_size);
        if (per_cu < 1) { fprintf(stderr, "kernel_launch: occupancy query says 0 blocks per CU\n"); per_cu = 1; }
        grid = cus;
        (void)hipGetLastError();
    }
    if (grid < 0) return;
    (void)hipMemsetAsync((char*)d_ws + WS_CTL, 0, CTL_ZERO_BYTES, stream);
    Args a{};
    for (int i = 0; i < 18; ++i) a.in[i] = (const float*)d_in[i];
    a.out = (float*)d_out; a.ws = (unsigned char*)d_ws;
#if MULTI_LAUNCH
    for (int ph = 0; ph < NPHASES; ++ph) { a.ph_lo = ph; a.ph_hi = ph + 1; hipLaunchKernelGGL(hymba_fwd, dim3(grid), dim3(512), LDS_BYTES, stream, a); }
#else
    a.ph_lo = 0; a.ph_hi = NPHASES;
    void* args[] = {&a};
    hipError_t e = hipLaunchCooperativeKernel((const void*)hymba_fwd, dim3(grid), dim3(512), args, LDS_BYTES, stream);
    if (e != hipSuccess) fprintf(stderr, "kernel_launch: cooperative launch failed: %s (grid %d)\n", hipGetErrorString(e), grid);
#endif
}
```

```cpp
#include <hip/hip_runtime.h>
#include <hip/hip_cooperative_groups.h>
#include <cstdio>
#include <cstdint>
namespace cg = cooperative_groups;
__device__ __forceinline__ int my_tid() { int t = threadIdx.x; asm volatile("" : "+v"(t)); return t; }
namespace pg8 {
#define PG8_LAS __attribute__((address_space(3)))
typedef unsigned short bf16_t;
typedef short bf16x8 __attribute__((ext_vector_type(8)));
typedef float f32x4 __attribute__((ext_vector_type(4)));
typedef unsigned u32x4 __attribute__((ext_vector_type(4)));
constexpr int BM = 256, BK = 64, HALF = 128, HTB = HALF * BK * 2  , STAGE_BYTES = 8 * HTB, NXCD = 8, WGM = 8;

__host__ __device__ __forceinline__ int lds_byte(int r, int c) { const int st = (r >> 4) * 2 + (c >> 5), rr = r & 15, cc = c & 31, ob = rr * 64 + cc * 2; return st * 1024 + (ob ^ (((ob >> 9) & 1) << 5)); }
__host__ __device__ __forceinline__ void stage_rc(int b, int& R, int& C) { const int st = b / 1024, sb = b % 1024, swz = sb ^ (((sb >> 9) & 1) << 5); R = (st >> 1) * 16 + swz / 64; C = (st & 1) * 32 + (swz % 64) / 2; }
__host__ __device__ __forceinline__ int perm32(int rho) { const int n = rho >> 4, i = rho & 15; return 8 * (i >> 2) + 4 * n + (i & 3); }

struct Unit { int pm, pn, idx; };
struct Gemm { const bf16_t* A; const bf16_t* Bt; int M, N, K; };

struct StaticOrder {
    int nM, nN, nwg, G, c;
    __host__ __device__ void init(int M, int N, int G_, int c_) { nM = M / BM; nN = N / BM; nwg = nM * nN; G = G_; c = c_; }
    __host__ __device__ bool next(int i, Unit& u) const {
        const long L = (long)i * G + c; if (L >= nwg) return false;
        int wgid = (int)L; { const int q = nwg / NXCD, r = nwg % NXCD, xcd = wgid % NXCD, off = wgid / NXCD; wgid = (xcd < r ? xcd * (q + 1) : r * (q + 1) + (xcd - r) * q) + off; }
        const int nig = WGM * nN, gid = wgid / nig, fm = gid * WGM, gsz = (nM - fm) < WGM ? (nM - fm) : WGM;
        u.pm = fm + ((wgid % nig) % gsz); u.pn = (wgid % nig) / gsz; u.idx = i; return true;
    }
    __device__ __forceinline__ void a_ready(const Unit&) const {}
    __device__ __forceinline__ void done(const Unit&) const {}
};
typedef float f32x2_cvt __attribute__((ext_vector_type(2))); typedef __bf16 bf16x2_cvt __attribute__((ext_vector_type(2)));
__device__ __forceinline__ unsigned cvt_pk_bf16(float lo, float hi) { const f32x2_cvt v = {lo, hi}; const bf16x2_cvt b = __builtin_convertvector(v, bf16x2_cvt); return __builtin_bit_cast(unsigned, b); }
__device__ __forceinline__ float fast_sigmoid(float x) { return __builtin_amdgcn_rcpf(1.0f + __expf(-x)); }
__device__ __forceinline__ float fast_silu(float x) { return x * fast_sigmoid(x); }
constexpr float QSCALE2 = 0.125f * 1.4426950408889634f;

__device__ __forceinline__ float row_sumsq(const float* RSQ, int row) {
    const f32x4* p = (const f32x4*)(RSQ + (size_t)row * 16);
    const f32x4 a = p[0], b = p[1], c = p[2], d = p[3];
    const f32x4 t = (a + b) + (c + d);
    return (t[0] + t[1]) + (t[2] + t[3]);
}
__device__ __forceinline__ float row_rstd(const float* RSQ, int row) { return __builtin_amdgcn_rsqf(row_sumsq(RSQ, row) * (1.0f / 1024.0f) + 1e-6f); }
__device__ __forceinline__ float row_rstd4(const float* RSQ, int row, int fq) {
    const f32x4 a = *((const f32x4*)(RSQ + (size_t)row * 16) + fq);
    float t = (a[0] + a[1]) + (a[2] + a[3]);
    t += __shfl_xor(t, 16); t += __shfl_xor(t, 32);
    return __builtin_amdgcn_rsqf(t * (1.0f / 1024.0f) + 1e-6f);
}
struct EpiWin {
    static constexpr bool PERM = true, AFTER_DRAIN = false;
    bf16_t *ACONV, *Q, *KCR, *VCR, *KS, *KW; float* G; const PG8_LAS float* RS;
    __device__ __forceinline__ void operator()(const f32x4 (&acc)[2][2][4][2], const Unit& u, int wr, int wc, int fr, int fq) const {
        const int pn = u.pn;
        const int R0 = u.pm * BM + wr * 64 + fr, c0 = wc * 32 + 8 * fq;
        if (pn == 9) {
#pragma unroll
            for (int ai = 0; ai < 2; ++ai)
#pragma unroll
                for (int m = 0; m < 4; ++m) {
                    const float rs = RS[u.idx * 256 + wr * 64 + fr + ai * HALF + m * 16];
                    if (c0 < 36) {
                        float* gp = G + (size_t)(R0 + ai * HALF + m * 16) * 36 + c0;
                        const f32x4 v0 = acc[ai][0][m][0] * rs, v1 = acc[ai][0][m][1] * rs;
#pragma unroll
                        for (int e = 0; e < 4; ++e) { gp[e] = fast_sigmoid(v0[e]); if (c0 + 4 + e < 36) gp[4 + e] = fast_sigmoid(v1[e]); }
                    }
                }
            return;
        }
        bf16_t* P0; int SA, SM, SB; float sc = 1.0f;
        if (pn < 2) { P0 = ACONV + (size_t)R0 * 512 + pn * 256 + c0; SA = 128 * 512; SM = 16 * 512; SB = 128; }
        else if (pn < 5) { P0 = Q + (size_t)R0 * 768 + (pn - 2) * 256 + c0; SA = 128 * 768; SM = 16 * 768; SB = 128; sc = QSCALE2; }
        else if (pn < 7) { P0 = (pn == 5 ? KCR : VCR) + (size_t)(R0 >> 4) * 4096 + (R0 & 15) * 64 + (c0 >> 6) * 1024 + (c0 & 63); SA = 8 * 4096; SM = 4096; SB = 2 * 1024; }
        else { P0 = (pn == 7 ? KS : KW) + (size_t)(R0 >> 12) * (4 * 4096 * 64) + (size_t)(R0 & 4095) * 64 + (size_t)(c0 >> 6) * (4096 * 64) + (c0 & 63); SA = 128 * 64; SM = 16 * 64; SB = 2 * 4096 * 64; }
#pragma unroll
        for (int ai = 0; ai < 2; ++ai)
#pragma unroll
            for (int m = 0; m < 4; ++m) {
                const float rs = RS[u.idx * 256 + wr * 64 + fr + ai * HALF + m * 16] * sc;
#pragma unroll
                for (int bj = 0; bj < 2; ++bj) {
                    const f32x4 v0 = acc[ai][bj][m][0] * rs, v1 = acc[ai][bj][m][1] * rs;
                    u32x4 w; w.x = cvt_pk_bf16(v0[0], v0[1]); w.y = cvt_pk_bf16(v0[2], v0[3]); w.z = cvt_pk_bf16(v1[0], v1[1]); w.w = cvt_pk_bf16(v1[2], v1[3]);
                    *(u32x4*)(P0 + (size_t)ai * SA + (size_t)m * SM + (size_t)bj * SB) = w;
                }
            }
    }
};
struct EpiVT {
    static constexpr bool PERM = false, AFTER_DRAIN = false;
    bf16_t *VST, *VWT; const PG8_LAS float* RS;
    __device__ __forceinline__ void operator()(const f32x4 (&acc)[2][2][4][2], const Unit& u, int wr, int wc, int fr, int fq) const {
        bf16_t* base = u.pn == 0 ? VST : VWT;
#pragma unroll
        for (int ai = 0; ai < 2; ++ai)
#pragma unroll
            for (int m = 0; m < 4; ++m) {
                const int row = u.pm * BM + ai * HALF + wr * 64 + m * 16 + 4 * fq;
                const int b = row >> 12, t = row & 4095;
                const f32x4 rs4 = *(const PG8_LAS f32x4*)(RS + u.idx * 256 + ai * HALF + wr * 64 + m * 16 + 4 * fq);
#pragma unroll
                for (int bj = 0; bj < 2; ++bj)
#pragma unroll
                    for (int n = 0; n < 2; ++n) {
                        const int col = bj * HALF + wc * 32 + n * 16 + fr, g = col >> 6, d = col & 63;
                        const f32x4 v = acc[ai][bj][m][n] * rs4;
                        unsigned long long w = (unsigned long long)cvt_pk_bf16(v[0], v[1]) | ((unsigned long long)cvt_pk_bf16(v[2], v[3]) << 32);
                        *(unsigned long long*)(base + ((size_t)(b * 4 + g) * 64 + d) * 4096 + t) = w;
                    }
            }
    }
};
struct EpiRes {
    static constexpr bool PERM = false, AFTER_DRAIN = false;
    bf16_t* XB; float* RSQ;
    __device__ __forceinline__ void operator()(const f32x4 (&acc)[2][2][4][2], const Unit& u, int wr, int wc, int fr, int fq) const {
#pragma unroll
        for (int ai = 0; ai < 2; ++ai)
#pragma unroll
            for (int m = 0; m < 4; ++m) {
                const int row = u.pm * BM + ai * HALF + wr * 64 + m * 16 + fr;
                bf16_t* xp = XB + (size_t)row * 1024 + u.pn * BM + wc * 32 + 4 * fq;
                unsigned long long b[2][2];
#pragma unroll
                for (int bj = 0; bj < 2; ++bj)
#pragma unroll
                    for (int n = 0; n < 2; ++n) b[bj][n] = *(const unsigned long long*)(xp + bj * HALF + n * 16);
                float ss = 0.f;
#pragma unroll
                for (int bj = 0; bj < 2; ++bj)
#pragma unroll
                    for (int n = 0; n < 2; ++n) {
                        const unsigned lo = (unsigned)b[bj][n], hi = (unsigned)(b[bj][n] >> 32);
                        f32x4 v = acc[ai][bj][m][n];
                        v[0] += __builtin_bit_cast(float, lo << 16); v[1] += __builtin_bit_cast(float, lo & 0xffff0000u);
                        v[2] += __builtin_bit_cast(float, hi << 16); v[3] += __builtin_bit_cast(float, hi & 0xffff0000u);
                        ss += (v[0] * v[0] + v[1] * v[1]) + (v[2] * v[2] + v[3] * v[3]);
                        *(unsigned long long*)(xp + bj * HALF + n * 16) = (unsigned long long)cvt_pk_bf16(v[0], v[1]) | ((unsigned long long)cvt_pk_bf16(v[2], v[3]) << 32);
                    }
                ss += __shfl_xor(ss, 16); ss += __shfl_xor(ss, 32);
                if (fq == 0) RSQ[(size_t)row * 16 + u.pn * 4 + wc] = ss;
            }
    }
};
struct EpiSwiglu {
    static constexpr bool PERM = true, AFTER_DRAIN = false;
    bf16_t* H; const PG8_LAS float* RS;
    __device__ __forceinline__ void operator()(const f32x4 (&acc)[2][2][4][2], const Unit& u, int wr, int wc, int fr, int fq) const {
#pragma unroll
        for (int ai = 0; ai < 2; ++ai)
#pragma unroll
            for (int m = 0; m < 4; ++m) {
                const int row = u.pm * BM + ai * HALF + wr * 64 + m * 16 + fr;
                const float rs = RS[u.idx * 256 + ai * HALF + wr * 64 + m * 16 + fr];
                const f32x4 g0 = acc[ai][0][m][0] * rs, g1 = acc[ai][0][m][1] * rs, u0 = acc[ai][1][m][0] * rs, u1 = acc[ai][1][m][1] * rs;
                float r[8];
#pragma unroll
                for (int e = 0; e < 4; ++e) { r[e] = fast_silu(g0[e]) * u0[e]; r[4 + e] = fast_silu(g1[e]) * u1[e]; }
                u32x4 w; w.x = cvt_pk_bf16(r[0], r[1]); w.y = cvt_pk_bf16(r[2], r[3]); w.z = cvt_pk_bf16(r[4], r[5]); w.w = cvt_pk_bf16(r[6], r[7]);
                *(u32x4*)(H + (size_t)row * 2816 + u.pn * 128 + wc * 32 + 8 * fq) = w;
            }
    }
};
struct EpiCmp {
    static constexpr bool PERM = false, AFTER_DRAIN = false;
    float* LOHI;
    __device__ __forceinline__ void operator()(const f32x4 (&acc)[2][2][4][2], const Unit& u, int wr, int wc, int fr, int fq) const {
#pragma unroll
        for (int ai = 0; ai < 2; ++ai)
#pragma unroll
            for (int m = 0; m < 4; ++m) {
                const size_t off = (size_t)(u.pm * BM + ai * HALF + wr * 64 + m * 16 + fr) * 512 + (u.pn & 1) * BM + wc * 32 + 4 * fq;
#pragma unroll
                for (int bj = 0; bj < 2; ++bj)
#pragma unroll
                    for (int n = 0; n < 2; ++n) *(f32x4*)(LOHI + off + bj * HALF + n * 16) = acc[ai][bj][m][n];
            }
    }
};
template <class Sched>
__device__ __forceinline__ void prep_rstd(const Sched& S, const float* RSQ, PG8_LAS float* RS, int tid) {
    Unit u;
    for (int i = 0; S.next(i, u); ++i)
        if ((tid >> 8) == (i & 1)) RS[i * 256 + (tid & 255)] = row_rstd(RSQ, u.pm * BM + (tid & 255));
    __syncthreads();
}
struct CmpOrder {
    int G, c;
    __device__ bool next(int i, Unit& u) const {
        u.idx = i;
        if (G == 256) {
            if (i > 0 || (c >> 3) >= 16) return false;
            const int b = c & 7, q = c >> 3, kv = q >> 3; u.pm = kv * 32 + b * 4 + ((q >> 1) & 3); u.pn = kv * 2 + (q & 1); return true;
        }
        const long L = (long)i * G + c; if (L >= 128) return false; u.pm = (int)(L >> 1); u.pn = ((u.pm >= 32) ? 2 : 0) + (int)(L & 1); return true; }
    __device__ __forceinline__ void a_ready(const Unit&) const {}
    __device__ __forceinline__ void done(const Unit&) const {}
};
template <class Epi, class Sched, bool ALIGN_EPI = false, bool SP2 = false, bool SWAP = false>
__device__ __forceinline__ void gemm_phase(PG8_LAS unsigned char* lds, const Gemm g, const Sched& S, const Epi& E) {
    const int tid = my_tid(), wid = __builtin_amdgcn_readfirstlane(tid >> 6), lane = tid & 63, wr = wid >> 2, wc = wid & 3, fr = lane & 15, fq = lane >> 4;
    const int K = g.K, nt = K / BK;
    unsigned voffA[2], voffB[2];
#pragma unroll
    for (int i = 0; i < 2; ++i) { int R, C; stage_rc(tid * 16 + i * 8192, R, C); const int Rb = Epi::PERM ? ((R & ~31) + perm32(R & 31)) : R;
        voffA[i] = (unsigned)(R * K + C) * 2u; voffB[i] = (unsigned)(Rb * K + C) * 2u; }
    const size_t kstep = (size_t)(BK * 2);
    const size_t hstep = (size_t)HALF * K * 2;
    const size_t tstep = 2 * hstep;
    const unsigned ldsw = (unsigned)wid * 1024u;
    const int aoff = lds_byte(wr * 64 + fr, fq * 8), boff = lds_byte(wc * 32 + fr, fq * 8);
#define PG8_SA(b, h) (((b) * 2 + (h)) * HTB)
#define PG8_SB(b, h) ((4 + (b) * 2 + (h)) * HTB)
#define PG8_STAGE(bufoff, gbase, voff) do { _Pragma("unroll") for (int _i = 0; _i < 2; ++_i) \
        __builtin_amdgcn_global_load_lds((const unsigned*)((const char*)(gbase) + (voff)[_i]), (PG8_LAS unsigned*)(lds + (bufoff) + ldsw + _i * 8192), 16, 0, 0); } while (0)
#define PG8_LDA(dst, b, h) do { _Pragma("unroll") for (int m = 0; m < 4; ++m) _Pragma("unroll") for (int k = 0; k < 2; ++k) dst[m][k] = *(const PG8_LAS bf16x8*)(lds + PG8_SA(b, h) + aoff + m * 2048 + k * 1024); } while (0)
#define PG8_LDB(dst, b, h) do { _Pragma("unroll") for (int n = 0; n < 2; ++n) _Pragma("unroll") for (int k = 0; k < 2; ++k) dst[n][k] = *(const PG8_LAS bf16x8*)(lds + PG8_SB(b, h) + boff + n * 2048 + k * 1024); } while (0)
#define PG8_MMA(ai, bj, At, Bt) do { __builtin_amdgcn_s_setprio(1); _Pragma("unroll") for (int m = 0; m < 4; ++m) _Pragma("unroll") for (int n = 0; n < 2; ++n) _Pragma("unroll") for (int k = 0; k < 2; ++k) \
        acc[ai][bj][m][n] = SWAP ? __builtin_amdgcn_mfma_f32_16x16x32_bf16(At[m][k], Bt[n][k], acc[ai][bj][m][n], 0, 0, 0) : __builtin_amdgcn_mfma_f32_16x16x32_bf16(Bt[n][k], At[m][k], acc[ai][bj][m][n], 0, 0, 0); __builtin_amdgcn_s_setprio(0); } while (0)
#define PG8_WAIT_V(n) asm volatile("s_waitcnt vmcnt(" #n ")" ::: "memory")
#define PG8_WAIT_L(n) asm volatile("s_waitcnt lgkmcnt(" #n ")" ::: "memory")
#define PG8_BAR __builtin_amdgcn_s_barrier()
#define PG8_SCHED __builtin_amdgcn_sched_barrier(0)
    Unit cur, nxt; int ui = 0;
    if (!S.next(0, cur)) return;
    f32x4 acc[2][2][4][2];
#pragma unroll
    for (int a = 0; a < 2; ++a)
#pragma unroll
        for (int b = 0; b < 2; ++b)
#pragma unroll
            for (int m = 0; m < 4; ++m)
#pragma unroll
                for (int n = 0; n < 2; ++n) acc[a][b][m][n] = (f32x4){0.f, 0.f, 0.f, 0.f};
    bf16x8 At[4][2], B0[2][2], B1[2][2];
    const char* cA = (const char*)g.A + (size_t)cur.pm * tstep; const char* cB = (const char*)g.Bt + (size_t)cur.pn * tstep;
    S.a_ready(cur);
    if constexpr (SP2) {
        PG8_STAGE(PG8_SB(0, 0), cB, voffB); PG8_STAGE(PG8_SB(0, 1), cB + hstep, voffB); PG8_STAGE(PG8_SA(0, 0), cA, voffA); PG8_STAGE(PG8_SA(0, 1), cA + hstep, voffA);
        if (wr == 1) PG8_BAR;
        PG8_WAIT_V(2); PG8_BAR;
        PG8_STAGE(PG8_SB(1, 0), cB + kstep, voffB); PG8_STAGE(PG8_SA(1, 0), cA + kstep, voffA); PG8_STAGE(PG8_SB(1, 1), cB + hstep + kstep, voffB);
        PG8_WAIT_V(6); PG8_BAR;
    } else {
        PG8_STAGE(PG8_SB(0, 0), cB, voffB); PG8_STAGE(PG8_SA(0, 0), cA, voffA); PG8_STAGE(PG8_SB(0, 1), cB + hstep, voffB); PG8_STAGE(PG8_SA(0, 1), cA + hstep, voffA);
        if (wr == 1) PG8_BAR;
        PG8_WAIT_V(4); PG8_BAR;
        PG8_STAGE(PG8_SB(1, 0), cB + kstep, voffB); PG8_STAGE(PG8_SA(1, 0), cA + kstep, voffA); PG8_STAGE(PG8_SB(1, 1), cB + hstep + kstep, voffB);
        PG8_WAIT_V(6); PG8_BAR;
    }
    for (;;) {
        const bool has_next = S.next(ui + 1, nxt);
        const char* nA = has_next ? (const char*)g.A + (size_t)nxt.pm * tstep : cA; const char* nB = has_next ? (const char*)g.Bt + (size_t)nxt.pn * tstep : cB;
        for (int t = 0; t < nt; t += 2) {
            const bool last = (t == nt - 2);
            const char* a1 = cA + (size_t)(t + 1) * kstep;
            const char* a2 = last ? nA : cA + (size_t)(t + 2) * kstep; const char* b2 = last ? nB : cB + (size_t)(t + 2) * kstep;
            const char* a3 = a2 + kstep; const char* b3 = b2 + kstep;
            if (last && has_next) S.a_ready(nxt);
            if constexpr (SP2) {
            PG8_LDB(B0, 0, 0); PG8_LDB(B1, 0, 1); PG8_SCHED; PG8_LDA(At, 0, 0); PG8_STAGE(PG8_SA(1, 1), a1 + hstep, voffA);
            PG8_WAIT_V(8); PG8_WAIT_L(0); PG8_BAR; PG8_MMA(0, 0, At, B0); PG8_MMA(0, 1, At, B1); PG8_BAR; PG8_SCHED;
            PG8_LDA(At, 0, 1); PG8_STAGE(PG8_SB(0, 0), b2, voffB); PG8_STAGE(PG8_SB(0, 1), b2 + hstep, voffB); PG8_STAGE(PG8_SA(0, 0), a2, voffA);
            PG8_WAIT_V(8); PG8_WAIT_L(0); PG8_BAR; PG8_MMA(1, 0, At, B0); PG8_MMA(1, 1, At, B1); PG8_BAR; PG8_SCHED;
            PG8_LDB(B0, 1, 0); PG8_LDB(B1, 1, 1); PG8_SCHED; PG8_LDA(At, 1, 0); PG8_STAGE(PG8_SA(0, 1), a2 + hstep, voffA);
            PG8_WAIT_V(8); PG8_WAIT_L(0); PG8_BAR; PG8_MMA(0, 0, At, B0); PG8_MMA(0, 1, At, B1); PG8_BAR; PG8_SCHED;
            PG8_LDA(At, 1, 1); PG8_STAGE(PG8_SB(1, 0), b3, voffB); PG8_STAGE(PG8_SB(1, 1), b3 + hstep, voffB); PG8_STAGE(PG8_SA(1, 0), a3, voffA);
            PG8_WAIT_V(8); PG8_WAIT_L(0); PG8_BAR; PG8_MMA(1, 0, At, B0); PG8_MMA(1, 1, At, B1); PG8_BAR; PG8_SCHED;
            } else {
            PG8_LDB(B0, 0, 0); PG8_SCHED; PG8_LDA(At, 0, 0); PG8_STAGE(PG8_SA(1, 1), a1 + hstep, voffA);
            PG8_WAIT_L(8); PG8_BAR; PG8_WAIT_L(0); PG8_MMA(0, 0, At, B0); PG8_BAR; PG8_SCHED;
            PG8_LDB(B1, 0, 1); PG8_STAGE(PG8_SB(0, 0), b2, voffB);
            PG8_BAR; PG8_WAIT_L(0); PG8_MMA(0, 1, At, B1); PG8_BAR;
            PG8_LDA(At, 0, 1); PG8_STAGE(PG8_SA(0, 0), a2, voffA);
            PG8_BAR; PG8_WAIT_L(0); PG8_MMA(1, 0, At, B0); PG8_BAR; PG8_SCHED;
            PG8_STAGE(PG8_SB(0, 1), b2 + hstep, voffB);
            PG8_WAIT_V(6); PG8_BAR; PG8_MMA(1, 1, At, B1); PG8_BAR;
            PG8_LDB(B0, 1, 0); PG8_SCHED; PG8_LDA(At, 1, 0); PG8_STAGE(PG8_SA(0, 1), a2 + hstep, voffA);
            PG8_WAIT_L(8); PG8_BAR; PG8_WAIT_L(0); PG8_MMA(0, 0, At, B0); PG8_BAR; PG8_SCHED;
            PG8_LDB(B1, 1, 1); PG8_STAGE(PG8_SB(1, 0), b3, voffB);
            PG8_BAR; PG8_WAIT_L(0); PG8_MMA(0, 1, At, B1); PG8_BAR;
            PG8_LDA(At, 1, 1); PG8_STAGE(PG8_SA(1, 0), a3, voffA);
            PG8_BAR; PG8_WAIT_L(0); PG8_MMA(1, 0, At, B0); PG8_BAR; PG8_SCHED;
            PG8_STAGE(PG8_SB(1, 1), b3 + hstep, voffB);
            PG8_WAIT_V(6); PG8_BAR; PG8_MMA(1, 1, At, B1); PG8_BAR;
            }
        }
        if constexpr (ALIGN_EPI) { if (wr == 0) PG8_BAR; }
        if constexpr (!Epi::AFTER_DRAIN) { E(acc, cur, wr, wc, fr, fq); S.done(cur); }
        if (!has_next) break;
#pragma unroll
        for (int a = 0; a < 2; ++a)
#pragma unroll
            for (int b = 0; b < 2; ++b)
#pragma unroll
                for (int m = 0; m < 4; ++m)
#pragma unroll
                    for (int n = 0; n < 2; ++n) acc[a][b][m][n] = (f32x4){0.f, 0.f, 0.f, 0.f};
        cur = nxt; cA = nA; cB = nB; ++ui;
        if constexpr (ALIGN_EPI) { if (wr == 1) PG8_BAR; }
    }
    PG8_WAIT_V(0);
    if constexpr (!ALIGN_EPI) { if (wr == 0) PG8_BAR; }
    PG8_BAR;
    if constexpr (Epi::AFTER_DRAIN) { E.fused(acc, cur, wr, wc, fr, fq, lds, wid, lane); S.done(cur); }
#undef PG8_SA
#undef PG8_SB
#undef PG8_STAGE
#undef PG8_LDA
#undef PG8_LDB
#undef PG8_MMA
#undef PG8_WAIT_V
#undef PG8_WAIT_L
#undef PG8_BAR
#undef PG8_SCHED
}
}
#define LAS __attribute__((address_space(3)))
typedef unsigned short bf16;
typedef short bf16x8 __attribute__((ext_vector_type(8)));
typedef short s16x4 __attribute__((ext_vector_type(4)));
typedef float f32x4 __attribute__((ext_vector_type(4)));
typedef unsigned u32x4 __attribute__((ext_vector_type(4)));
typedef unsigned u32x2 __attribute__((ext_vector_type(2)));

constexpr int NB = 8, T = 4096, D = 1024, M = NB * T, DEPTH = 4;
constexpr int IN_COLS = 2852, DFF = 2816;
constexpr float EPS = 1e-6f;
constexpr float LOG2E = 1.4426950408889634f;
constexpr size_t MiB = 1u << 20;
constexpr size_t WS_X = 0, WS_XN = 128 * MiB, WS_ACONV = 192 * MiB, WS_Q = 224 * MiB, WS_KCR = 272 * MiB, WS_VCR = 288 * MiB, WS_KS = 304 * MiB, WS_KW = 320 * MiB,
                 WS_VST = 336 * MiB, WS_VWT = 352 * MiB, WS_HFF = 192 * MiB,
                 WS_WSET = 368 * MiB, WSET_BYTES = 27 * MiB,
                 OFF_WIN = 0, OFF_WOUT = 6 * MiB, OFF_WGU = 8 * MiB, OFF_WD = 19 * MiB, OFF_CMPW = 25 * MiB,
                 WS_XB = 422 * MiB, WS_LOHI = 0, WS_ASCR = 32 * MiB,
                 WS_G = 486 * MiB, WS_KC = 491 * MiB, WS_VCT = 492 * MiB, WS_PE = 493 * MiB, WS_RSQ = 494 * MiB, WS_CTL = 498 * MiB, WS_END = 499 * MiB;
constexpr int LDS_BYTES = 163840, MISC_OFF = 163840 - 512, CTL_ZERO_BYTES = 16384;
constexpr int NPH = 11, NPHASES = DEPTH * NPH + 1;

struct Args {
    const float* in[18]; float* out; unsigned char* ws; int ph_lo, ph_hi;
};
#ifndef USE_PT
#define USE_PT 0
#endif
struct PT {
    LAS const unsigned long long* t; unsigned char* ws; const Args* ap;
#if USE_PT
    __device__ __forceinline__ unsigned long long raw(int i) const { const unsigned long long v = t[i]; return (unsigned long long)__builtin_amdgcn_readfirstlane((unsigned)v) | ((unsigned long long)__builtin_amdgcn_readfirstlane((unsigned)(v >> 32)) << 32); }
#else
    __device__ __forceinline__ unsigned long long raw(int i) const { return i < 18 ? (unsigned long long)ap->in[i] : (i == 18 ? (unsigned long long)ap->out : (unsigned long long)ap->ws); }
#endif
    __device__ __forceinline__ const float* in(int i) const { return (const float*)raw(i); }
};

__device__ __forceinline__ unsigned f2bf(float f) { unsigned u = __builtin_bit_cast(unsigned, f); return (u + 0x7fffu + ((u >> 16) & 1u)) >> 16; }
typedef float f32x2_cv __attribute__((ext_vector_type(2))); typedef __bf16 bf16x2_cv __attribute__((ext_vector_type(2)));
__device__ __forceinline__ unsigned pk2(float lo, float hi) { const f32x2_cv v = {lo, hi}; const bf16x2_cv b = __builtin_convertvector(v, bf16x2_cv); return __builtin_bit_cast(unsigned, b); }
__device__ __forceinline__ float bf2f(unsigned short h) { return __builtin_bit_cast(float, (unsigned)h << 16); }
__device__ __forceinline__ float wave_sum(float v) {
#pragma unroll
    for (int o = 1; o < 64; o <<= 1) v += __shfl_xor(v, o);
    return v;
}
#define LDS_WAIT() asm volatile("s_waitcnt lgkmcnt(0)" ::: "memory")

__device__ __forceinline__ void transpose_item(const float* W, int ldw, int ncols, bf16* WTrow0, int ldt, LAS float* scr, int k0, int n0, int lane, const float* gain = nullptr) {
    const int cq = lane & 15, kr = lane >> 4;
#pragma unroll 8
    for (int i = 0; i < 16; ++i) {
        const int kk = 4 * i + kr, n = n0 + 4 * cq;
        f32x4 v = {0.f, 0.f, 0.f, 0.f};
        if (n < ncols) v = *(const f32x4*)(W + (size_t)(k0 + kk) * ldw + n);
        LAS float* d = scr + kk * 65 + 4 * cq;
        d[0] = v[0]; d[1] = v[1]; d[2] = v[2]; d[3] = v[3];
    }
    LDS_WAIT(); asm volatile("" ::: "memory");
    const int c = lane & 7;
    f32x4 ga = {1.f, 1.f, 1.f, 1.f}, gb = ga;
    if (gain) { ga = *(const f32x4*)(gain + k0 + 8 * c); gb = *(const f32x4*)(gain + k0 + 8 * c + 4); }
#pragma unroll
    for (int j = 0; j < 8; ++j) { const int n = (lane >> 3) + 8 * j; const LAS float* s = scr + (8 * c) * 65 + n;
        u32x4 o; o.x = pk2(s[0 * 65] * ga[0], s[1 * 65] * ga[1]); o.y = pk2(s[2 * 65] * ga[2], s[3 * 65] * ga[3]); o.z = pk2(s[4 * 65] * gb[0], s[5 * 65] * gb[1]); o.w = pk2(s[6 * 65] * gb[2], s[7 * 65] * gb[3]);
        *(u32x4*)(WTrow0 + (size_t)n * ldt + k0 + 8 * c) = o; }
    LDS_WAIT(); asm volatile("" ::: "memory");
}
__device__ __forceinline__ int win_row(int n0) {
    if (n0 < 2048) return n0;
    if (n0 < 2304) return 2560 + (n0 - 2048);
    if (n0 < 2560) return 2048 + (n0 - 2304);
    if (n0 < 2816) return 2816 + (n0 - 2560);
    return 2304 + (n0 - 2816);
}
__device__ __forceinline__ int wgu_row(int n0) { const int h = n0 < DFF ? n0 : n0 - DFF; return 256 * (h >> 7) + (h & 127) + (n0 < DFF ? 0 : 128); }

__device__ __forceinline__ void prologue_layer(const PT& a, int layer, LAS unsigned char* lds, int blk, int G) {
    const int tid = my_tid(), lane = tid & 63, wave = tid >> 6;
    LAS float* scr = (LAS float*)(lds + wave * 17408);
    const int gw = blk * 8 + wave, NGW = G * 8;
    unsigned char* ws = a.ws; unsigned char* wset = ws + WS_WSET + (size_t)(layer & 1) * WSET_BYTES;
    bf16* WIN = (bf16*)(wset + OFF_WIN); bf16* WOUT = (bf16*)(wset + OFF_WOUT); bf16* WGU = (bf16*)(wset + OFF_WGU); bf16* WD = (bf16*)(wset + OFF_WD); bf16* CMPW = (bf16*)(wset + OFF_CMPW);
    const float* g1 = a.in(1) + (size_t)layer * D; const float* g2 = a.in(14) + (size_t)layer * D;
    const float* w_in = a.in(2) + (size_t)layer * D * IN_COLS;
    const float* w_out = a.in(13) + (size_t)layer * D * D;
    const float* w_gu = a.in(15) + (size_t)layer * D * 2 * DFF;
    const float* w_dn = a.in(16) + (size_t)layer * DFF * D;
    const float* kw1 = a.in(8) + (size_t)layer * 32 * 64 * 256;
    const float* vw1 = a.in(11) + (size_t)layer * 32 * 64 * 256;
    constexpr int I_IN = 16 * 45, I_OUT = 16 * 16, I_GU = 16 * 88, I_DN = 44 * 16, I_C = 16 * 4;
    constexpr int NIT = I_IN + I_OUT + I_GU + I_DN + 4 * I_C;
    for (int it = gw; it < NIT; it += NGW) {
        int r = it;
        if (r < I_IN) { const int kb = r / 45, nb = r % 45; transpose_item(w_in, IN_COLS, IN_COLS, WIN + (size_t)win_row(64 * nb) * D, D, scr, 64 * kb, 64 * nb, lane, g1); continue; } r -= I_IN;
        if (r < I_OUT) { const int kb = r / 16, nb = r % 16; transpose_item(w_out, D, D, WOUT + (size_t)(64 * nb) * D, D, scr, 64 * kb, 64 * nb, lane); continue; } r -= I_OUT;
        if (r < I_GU) { const int kb = r / 88, nb = r % 88; transpose_item(w_gu, 2 * DFF, 2 * DFF, WGU + (size_t)wgu_row(64 * nb) * D, D, scr, 64 * kb, 64 * nb, lane, g2); continue; } r -= I_GU;
        if (r < I_DN) { const int kb = r / 16, nb = r % 16; transpose_item(w_dn, D, D, WD + (size_t)(64 * nb) * DFF, DFF, scr, 64 * kb, 64 * nb, lane); continue; } r -= I_DN;
        { const int q = r / I_C, rr = r % I_C, kb = rr / 4, nb = rr % 4;
          const float* src = ((q < 2) ? kw1 : vw1) + (size_t)(q & 1) * 1024 * 256;
          transpose_item(src, 256, 256, CMPW + (size_t)(q * 256 + 64 * nb) * D, D, scr, 64 * kb, 64 * nb, lane); }
    }
    { u32x4 z = {0u, 0u, 0u, 0u}; u32x4* p = (u32x4*)(WIN + (size_t)(2304 + 64) * D);
      for (int i = blk * 512 + tid; i < 192 * D / 8; i += G * 512) p[i] = z; }
    if (blk < 16) {
        __syncthreads();
        const int kvb = blk >> 3, cg = blk & 7;
        const float* pe = (kvb == 0 ? a.in(7) : a.in(10)) + (size_t)layer * 2048;
        const float* w1 = kvb == 0 ? kw1 : vw1;
        LAS float* red = (LAS float*)lds;
        const int c = tid & 31, lg = tid >> 5;
        float s = 0.f;
#pragma unroll 16
        for (int i = 0; i < 128; ++i) { const int ld = lg * 128 + i; s += pe[ld] * w1[(size_t)ld * 256 + cg * 32 + c]; }
        red[lg * 32 + c] = s;
        __syncthreads();
        if (tid < 32) { float t = 0.f;
#pragma unroll
            for (int j = 0; j < 16; ++j) t += red[j * 32 + tid];
            ((float*)(ws + WS_PE))[(layer & 1) * 512 + kvb * 256 + cg * 32 + tid] = t; }
        __syncthreads();
    }
}

__device__ __forceinline__ void first_rows(const float* x, bf16* XB, float* RSQ, int blk, int G) {
    const int tid = my_tid(), lane = tid & 63, wave = tid >> 6;
    const int gw = blk * 8 + wave, NGW = G * 8;
    for (int m = gw; m < M; m += NGW) {
        const f32x4* xr = (const f32x4*)(x + (size_t)m * D) + lane;
        unsigned long long* o8 = (unsigned long long*)(XB + (size_t)m * D) + lane;
        float s = 0.f;
#pragma unroll
        for (int j = 0; j < 4; ++j) { const f32x4 v = xr[64 * j]; s += (v.x * v.x + v.y * v.y) + (v.z * v.z + v.w * v.w); o8[64 * j] = (unsigned long long)pk2(v.x, v.y) | ((unsigned long long)pk2(v.z, v.w) << 32); }
        s = wave_sum(s);
        if (lane < 16) RSQ[(size_t)m * 16 + lane] = lane == 0 ? s : 0.f;
    }
}
__device__ __forceinline__ void final_rows(const bf16* xb, const float* RSQ, const float* gain, float* out, int blk, int G) {
    const int tid = my_tid(), lane = tid & 63, wave = tid >> 6;
    const int gw = blk * 8 + wave, NGW = G * 8;
    f32x4 gv[4];
#pragma unroll
    for (int j = 0; j < 4; ++j) gv[j] = *((const f32x4*)gain + lane + 64 * j);
    for (int m = gw; m < M; m += NGW) {
        const float rstd = 1.0f / sqrtf(pg8::row_sumsq(RSQ, m) * (1.f / D) + EPS);
        const unsigned long long* xr = (const unsigned long long*)(xb + (size_t)m * D) + lane;
        f32x4* o = (f32x4*)(out + (size_t)m * D) + lane;
#pragma unroll
        for (int j = 0; j < 4; ++j) {
            const unsigned long long w = xr[64 * j]; const unsigned lo = (unsigned)w, hi = (unsigned)(w >> 32);
            const f32x4 v = {__builtin_bit_cast(float, lo << 16), __builtin_bit_cast(float, lo & 0xffff0000u), __builtin_bit_cast(float, hi << 16), __builtin_bit_cast(float, hi & 0xffff0000u)};
            o[64 * j] = v * rstd * gv[j];
        }
    }
}

__device__ __forceinline__ void conv_phase(const PT& a, int layer, LAS unsigned char* lds, int blk, int G) {
    const int tid = my_tid(), lane = tid & 63, wave = tid >> 6;
    LAS float* Y = (LAS float*)lds;
    LAS float* C = Y + 62 * 256;
    const bf16* ACONV = (const bf16*)(a.ws + WS_ACONV);
    bf16* MIX = (bf16*)(a.ws + WS_XN);
    const float* cw = a.in(3) + (size_t)layer * 31 * 256;
    const float* cb = a.in(4) + (size_t)layer * 256;
    const float* lg = a.in(5) + (size_t)layer * 256;
    const float* lb = a.in(6) + (size_t)layer * 256;
    const int c = tid & 255, half = tid >> 8;
    float w[31];
#pragma unroll
    for (int k = 0; k < 31; ++k) w[k] = cw[k * 256 + c];
    const float bias = cb[c];
    const f32x4 g4 = *((const f32x4*)lg + lane), b4 = *((const f32x4*)lb + lane);
    const int cq = blk >> 3, cnt = (G == 256) ? (cq < 16 ? 2 : 6) : 0, tbase = (blk & 7) * 128 + (cq < 16 ? 2 * cq : 32 + 6 * (cq - 16));
    u32x4 ru[4], rv[4];
#define CONV_FETCH(tile_) do { const int b_ = (tile_) >> 7, t0_ = ((tile_) & 127) * 32; \
        _Pragma("unroll") for (int k_ = 0; k_ < 4; ++k_) { const int idx_ = tid + 512 * k_; const int t_ = t0_ - 30 + (idx_ >> 5); \
            ru[k_] = (u32x4){0u, 0u, 0u, 0u}; rv[k_] = ru[k_]; \
            if (idx_ < 62 * 32 && t_ >= 0) { const bf16* p_ = ACONV + ((size_t)b_ * T + t_) * 512 + (idx_ & 31) * 8; ru[k_] = *(const u32x4*)p_; rv[k_] = *(const u32x4*)(p_ + 256); } } } while (0)
    const int tl0 = (G == 256) ? 0 : blk, tlim = (G == 256) ? cnt : 1024, tstep = (G == 256) ? 1 : G;
    if (tl0 < tlim) CONV_FETCH((G == 256) ? tbase + tl0 : tl0);
    for (int tl = tl0; tl < tlim; tl += tstep) {
        const int tile = (G == 256) ? tbase + tl : tl;
        const int b = tile >> 7, t0 = (tile & 127) * 32;
#pragma unroll
        for (int k = 0; k < 4; ++k) {
            const int idx = tid + 512 * k;
            if (idx < 62 * 32) {
                const int rr = idx >> 5, ch = idx & 31;
                f32x4 y0, y1;
                const u32x4 u = ru[k], v = rv[k];
#pragma unroll
                for (int e = 0; e < 4; ++e) {
                    const float ulo = __builtin_bit_cast(float, u[e] << 16), uhi = __builtin_bit_cast(float, u[e] & 0xffff0000u);
                    const float vlo = __builtin_bit_cast(float, v[e] << 16), vhi = __builtin_bit_cast(float, v[e] & 0xffff0000u);
                    const float r0 = ulo * pg8::fast_sigmoid(vlo), r1 = uhi * pg8::fast_sigmoid(vhi);
                    if (e < 2) { y0[2 * e] = r0; y0[2 * e + 1] = r1; } else { y1[2 * (e - 2)] = r0; y1[2 * (e - 2) + 1] = r1; }
                }
                *(LAS f32x4*)(Y + rr * 256 + ch * 8) = y0; *(LAS f32x4*)(Y + rr * 256 + ch * 8 + 4) = y1;
            }
        }
        __syncthreads();
        if (tl + tstep < tlim) CONV_FETCH((G == 256) ? tbase + tl + tstep : tl + tstep);
        {
            float acc[16];
#pragma unroll
            for (int tt = 0; tt < 16; ++tt) acc[tt] = bias;
#pragma unroll
            for (int r2 = 0; r2 < 46; ++r2) {
                const float yv = Y[(half * 16 + r2) * 256 + c];
#pragma unroll
                for (int tt = 0; tt < 16; ++tt) { const int k = r2 - tt; if (k >= 0 && k <= 30) acc[tt] += w[k] * yv; }
            }
#pragma unroll
            for (int tt = 0; tt < 16; ++tt) C[(half * 16 + tt) * 256 + c] = acc[tt];
        }
        __syncthreads();
#pragma unroll
        for (int i = 0; i < 4; ++i) {
            const int tok = wave * 4 + i;
            const f32x4 v = *(const LAS f32x4*)(C + tok * 256 + lane * 4);
            const float mu = wave_sum((v.x + v.y) + (v.z + v.w)) * (1.f / 256.f);
            const f32x4 dv = v - mu;
            const float var = wave_sum((dv.x * dv.x + dv.y * dv.y) + (dv.z * dv.z + dv.w * dv.w)) * (1.f / 256.f);
            const float rstd = 1.0f / sqrtf(var + EPS);
            f32x4 y = dv * rstd * g4 + b4;
            y.x = pg8::fast_silu(y.x); y.y = pg8::fast_silu(y.y); y.z = pg8::fast_silu(y.z); y.w = pg8::fast_silu(y.w);
            *(unsigned long long*)(MIX + ((size_t)b * T + t0 + tok) * D + lane * 4) = (unsigned long long)pk2(y.x, y.y) | ((unsigned long long)pk2(y.z, y.w) << 32);
        }
    }
    __syncthreads();
}

__device__ __forceinline__ void cmp2_phase(const PT& a, int layer, LAS unsigned char* lds, int blk, int G) {
    const int tid = my_tid(), lane = tid & 63, wave = tid >> 6;
    LAS float* hL = (LAS float*)(lds + wave * 4096);
    LAS float* W2L = (LAS float*)(lds + 32768);
    const float* LOHI = (const float*)(a.ws + WS_LOHI);
    const float* PE = (const float*)(a.ws + WS_PE) + (layer & 1) * 512;
    bf16* KC = (bf16*)(a.ws + WS_KC); bf16* VCT = (bf16*)(a.ws + WS_VCT);
    const int gw = blk * 8 + wave, NGW = G * 8;
    const int nround = (G == 256) ? 2 : (2 * NB * 255 + NGW - 1) / NGW;
    for (int rd = 0; rd < nround; ++rd) {
        int kv, b, n; bool act;
        if (G == 256) {
            const int lw = (blk >> 3) * 8 + wave; kv = rd; b = blk & 7; n = lw; act = lw < 255;
            const float* w2g = (kv == 0 ? a.in(9) : a.in(12)) + (size_t)layer * 256 * 64;
            __syncthreads();
#pragma unroll
            for (int i = 0; i < 8; ++i) *(LAS f32x4*)(W2L + (tid + 512 * i) * 4) = *((const f32x4*)w2g + tid + 512 * i);
            __syncthreads();
        } else { const int gi = gw + rd * NGW; act = gi < 2 * NB * 255; kv = act ? gi / (NB * 255) : 0; const int rem = act ? gi % (NB * 255) : 0; b = rem / 255; n = rem % 255; }
        if (!act) continue;
        const float* w2 = (kv == 0 ? a.in(9) : a.in(12)) + (size_t)layer * 256 * 64;
        const f32x4 pe4 = *((const f32x4*)(PE + kv * 256) + lane);
#pragma unroll
        for (int g = 0; g < 4; ++g) {
            const size_t R0 = (size_t)kv * 8192 + ((size_t)b * 256 + n) * 4 + g, R1 = R0 + 4;
            const f32x4 lo = *((const f32x4*)(LOHI + R0 * 512) + lane), hi = *((const f32x4*)(LOHI + R1 * 512 + 256) + lane);
            f32x4 h = lo + hi + pe4;
            h.x = pg8::fast_silu(h.x); h.y = pg8::fast_silu(h.y); h.z = pg8::fast_silu(h.z); h.w = pg8::fast_silu(h.w);
            *(LAS f32x4*)(hL + g * 256 + lane * 4) = h;
        }
        LDS_WAIT(); asm volatile("" ::: "memory");
        float acc[4] = {0.f, 0.f, 0.f, 0.f};
#pragma unroll 4
        for (int j4 = 0; j4 < 64; ++j4) {
            float wv[4];
#pragma unroll
            for (int e = 0; e < 4; ++e) wv[e] = (G == 256) ? W2L[(4 * j4 + e) * 64 + lane] : w2[(4 * j4 + e) * 64 + lane];
#pragma unroll
            for (int g = 0; g < 4; ++g) { const f32x4 hv = *(const LAS f32x4*)(hL + g * 256 + 4 * j4); acc[g] += hv.x * wv[0] + hv.y * wv[1] + hv.z * wv[2] + hv.w * wv[3]; }
        }
        LDS_WAIT(); asm volatile("" ::: "memory");
#pragma unroll
        for (int g = 0; g < 4; ++g) {
            const unsigned short o = (unsigned short)f2bf(acc[g]);
            if (kv == 0) { KC[((size_t)(b * 4 + g) * 256 + n) * 64 + lane] = o; if (n == 254) KC[((size_t)(b * 4 + g) * 256 + 255) * 64 + lane] = 0; }
            else { VCT[((size_t)(b * 4 + g) * 64 + lane) * 256 + n] = o; if (n == 254) VCT[((size_t)(b * 4 + g) * 64 + lane) * 256 + 255] = 0; }
        }
    }
    __syncthreads();
}
namespace att {
constexpr int KSTR = 128, TILE_B = 64 * KSTR;
constexpr int NBUF = 4, OFF_K = 0, OFF_V = NBUF * TILE_B, OFF_IMP = 2 * NBUF * TILE_B, OFF_SELM = OFF_IMP + 128 * 65 * 4, OFF_BUN = OFF_SELM + 1024, OFF_Q = OFF_BUN + 64;
constexpr float NEG = -1.0e30f, M0REF = -40.0f;
struct P { unsigned char* ws; f32x4* scr; };

#define MFMA16(a, b, c) __builtin_amdgcn_mfma_f32_16x16x32_bf16((a), (b), (c), 0, 0, 0)

__device__ __forceinline__ void qk_tile3(f32x4 (&st)[3][4], const LAS unsigned char* Kl, const LAS unsigned char* QL, int fr, int fq) {
    bf16x8 kf[4][2];
#pragma unroll
    for (int kt = 0; kt < 4; ++kt)
#pragma unroll
        for (int ks = 0; ks < 2; ++ks) kf[kt][ks] = *(const LAS bf16x8*)(Kl + (16 * kt + fr) * KSTR + (((4 * ks + fq) ^ (fr & 7)) << 4));
#pragma unroll
    for (int r = 0; r < 3; ++r)
#pragma unroll
        for (int kt = 0; kt < 4; ++kt) {
            f32x4 acc = {0.f, 0.f, 0.f, 0.f};
#pragma unroll
            for (int ks = 0; ks < 2; ++ks) acc = MFMA16(kf[kt][ks], *(const LAS bf16x8*)(QL + (r * 2 + ks) * 1024), acc);
            st[r][kt] = acc;
        }
}
__device__ __forceinline__ void qk_tile3_aug(f32x4 (&st)[3][4], const LAS unsigned char* Kl, const LAS unsigned char* QL, const unsigned (&qaw)[3], const unsigned (&kaw)[4], int fr, int fq) {
#pragma unroll
    for (int kt = 0; kt < 4; ++kt) {
        const LAS unsigned char* krow = Kl + (16 * kt + fr) * KSTR;
        const bf16x8 kf0 = *(const LAS bf16x8*)(krow + ((fq ^ (fr & 7)) << 4));
        const bf16x8 kf1 = *(const LAS bf16x8*)(krow + (((4 + fq) ^ (fr & 7)) << 4));
        const u32x4 ka = {kaw[kt], 0u, 0u, 0u};
#pragma unroll
        for (int r = 0; r < 3; ++r) {
            const u32x4 qa = {qaw[r], 0u, 0u, 0u};
            f32x4 acc = MFMA16(__builtin_bit_cast(bf16x8, ka), __builtin_bit_cast(bf16x8, qa), ((f32x4){0.f, 0.f, 0.f, 0.f}));
            acc = MFMA16(kf0, *(const LAS bf16x8*)(QL + (r * 2) * 1024), acc);
            st[r][kt] = MFMA16(kf1, *(const LAS bf16x8*)(QL + (r * 2 + 1) * 1024), acc);
        }
    }
}
__device__ __forceinline__ void pv_tile3(f32x4 (&o)[3][4], const LAS unsigned char* Vl, const f32x4 (&p)[3][4], int fr, int fq) {
    bf16x8 pb[3][2];
#pragma unroll
    for (int r = 0; r < 3; ++r)
#pragma unroll
        for (int kk = 0; kk < 2; ++kk) {
            u32x4 w; w.x = pk2(p[r][2 * kk][0], p[r][2 * kk][1]); w.y = pk2(p[r][2 * kk][2], p[r][2 * kk][3]); w.z = pk2(p[r][2 * kk + 1][0], p[r][2 * kk + 1][1]); w.w = pk2(p[r][2 * kk + 1][2], p[r][2 * kk + 1][3]);
            pb[r][kk] = __builtin_bit_cast(bf16x8, w);
        }
#pragma unroll
    for (int dt = 0; dt < 4; ++dt)
#pragma unroll
        for (int kk = 0; kk < 2; ++kk) {
            const LAS unsigned char* vrow = Vl + (16 * dt + fr) * KSTR + 8 * (fq & 1);
            const u32x2 v0 = *(const LAS u32x2*)(vrow + (((4 * kk + (fq >> 1)) ^ (fr & 7)) << 4)), v1 = *(const LAS u32x2*)(vrow + (((4 * kk + 2 + (fq >> 1)) ^ (fr & 7)) << 4));
            u32x4 w; w.x = v0.x; w.y = v0.y; w.z = v1.x; w.w = v1.y;
            const bf16x8 vf = __builtin_bit_cast(bf16x8, w);
#pragma unroll
            for (int r = 0; r < 3; ++r) o[r][dt] = MFMA16(vf, pb[r][kk], o[r][dt]);
        }
}
__device__ __forceinline__ float ex2(float x) { return __builtin_amdgcn_exp2f(x); }
__device__ __forceinline__ float rmax4(float a) {
    unsigned x = __builtin_bit_cast(unsigned, a);
    auto r1 = __builtin_amdgcn_permlane16_swap(x, x, false, false);
    unsigned u0 = r1[0], u1 = r1[1];
    asm volatile("" : "+v"(u0), "+v"(u1));
    a = fmaxf(__builtin_bit_cast(float, u0), __builtin_bit_cast(float, u1));
    x = __builtin_bit_cast(unsigned, a);
    auto r2 = __builtin_amdgcn_permlane32_swap(x, x, false, false);
    u0 = r2[0]; u1 = r2[1];
    asm volatile("" : "+v"(u0), "+v"(u1));
    return fmaxf(__builtin_bit_cast(float, u0), __builtin_bit_cast(float, u1));
}
__device__ __forceinline__ float max16(const f32x4 (&v)[4]) {
    float a = fmaxf(fmaxf(v[0][0], v[0][1]), fmaxf(v[0][2], v[0][3]));
#pragma unroll
    for (int kt = 1; kt < 4; ++kt) a = fmaxf(a, fmaxf(fmaxf(v[kt][0], v[kt][1]), fmaxf(v[kt][2], v[kt][3])));
    return rmax4(a);
}

__device__ __forceinline__ void qk_half(f32x4 (&st)[3][2], const LAS unsigned char* Kl, const LAS unsigned char* QL, const unsigned (&qaw)[3], const unsigned (&kaw)[4], int hf, const float (&cinit)[3], int fr, int fq) {
    const int sw = fr & 7;
#pragma unroll
    for (int k2 = 0; k2 < 2; ++k2) {
        const LAS unsigned char* krow = Kl + (32 * hf + 16 * k2 + fr) * KSTR;
        const bf16x8 kf0 = *(const LAS bf16x8*)(krow + ((fq ^ sw) << 4));
        const bf16x8 kf1 = *(const LAS bf16x8*)(krow + (((4 + fq) ^ sw) << 4));
        const u32x4 ka = {hf ? kaw[2 + k2] : kaw[k2], 0u, 0u, 0u};
#pragma unroll
        for (int r = 0; r < 3; ++r) {
            const u32x4 qa = {qaw[r], 0u, 0u, 0u};
            f32x4 acc = MFMA16(__builtin_bit_cast(bf16x8, ka), __builtin_bit_cast(bf16x8, qa), ((f32x4){cinit[r], cinit[r], cinit[r], cinit[r]}));
            acc = MFMA16(kf0, *(const LAS bf16x8*)(QL + (r * 2) * 1024), acc);
            st[r][k2] = MFMA16(kf1, *(const LAS bf16x8*)(QL + (r * 2 + 1) * 1024), acc);
        }
    }
}
__device__ __forceinline__ float max8(const f32x4 (&v)[2]) { return fmaxf(fmaxf(fmaxf(v[0][0], v[0][1]), fmaxf(v[0][2], v[0][3])), fmaxf(fmaxf(v[1][0], v[1][1]), fmaxf(v[1][2], v[1][3]))); }
template <int MODE>
__device__ __forceinline__ void flash_step(const LAS unsigned char* Kl, const LAS unsigned char* Vl, const LAS unsigned char* QL, const unsigned (&qaw)[3], const unsigned (&kaw)[4], const float (&sl2)[3],
                                           int rel, int dj, bool sel, bool need_mask, float (&m)[3], f32x4 (&O)[3][5], int fr, int fq) {
    constexpr float THR = 6.0f;
    const float djf = (float)dj;
    const int sw = fr & 7;
    float cmo[3];
#pragma unroll
    for (int r = 0; r < 3; ++r) cmo[r] = sl2[r] * djf - m[r];
#pragma unroll 1
    for (int hf = 0; hf < 2; ++hf) {
        f32x4 st[3][2];
        bf16x8 kfa[2], kfb[2];
#pragma unroll
        for (int k2 = 0; k2 < 2; ++k2) {
            const LAS unsigned char* krow = Kl + (32 * hf + 16 * k2 + fr) * KSTR;
            kfa[k2] = *(const LAS bf16x8*)(krow + ((fq ^ sw) << 4));
            kfb[k2] = *(const LAS bf16x8*)(krow + (((4 + fq) ^ sw) << 4));
        }
        __builtin_amdgcn_s_setprio(1);
#pragma unroll
        for (int r = 0; r < 3; ++r) {
            const u32x4 qa = {qaw[r], 0u, 0u, 0u};
#pragma unroll
            for (int k2 = 0; k2 < 2; ++k2) {
                const u32x4 ka = {hf ? kaw[2 + k2] : kaw[k2], 0u, 0u, 0u};
                f32x4 acc = MFMA16(__builtin_bit_cast(bf16x8, ka), __builtin_bit_cast(bf16x8, qa), ((f32x4){cmo[r], cmo[r], cmo[r], cmo[r]}));
                acc = MFMA16(kfa[k2], *(const LAS bf16x8*)(QL + (r * 2) * 1024), acc);
                st[r][k2] = MFMA16(kfb[k2], *(const LAS bf16x8*)(QL + (r * 2 + 1) * 1024), acc);
            }
        }
        __builtin_amdgcn_s_setprio(0);
        if (need_mask) {
#pragma unroll
            for (int k2 = 0; k2 < 2; ++k2)
#pragma unroll
                for (int e = 0; e < 4; ++e) {
                    const int pr = rel + 32 * hf + 16 * k2 + e;
                    bool ok = pr <= 0;
                    if (MODE == 0) ok = ok && sel; else ok = ok && (pr > -512);
#pragma unroll
                    for (int r = 0; r < 3; ++r) st[r][k2][e] = ok ? st[r][k2][e] : NEG;
                }
        }
        float a[3];
#pragma unroll
        for (int r = 0; r < 3; ++r) a[r] = fmaxf(fmaxf(fmaxf(st[r][0][0], st[r][0][1]), fmaxf(st[r][0][2], st[r][0][3])), fmaxf(fmaxf(st[r][1][0], st[r][1][1]), fmaxf(st[r][1][2], st[r][1][3])));
        if (__any(fmaxf(fmaxf(a[0], a[1]), a[2]) > THR)) {
#pragma unroll
            for (int r = 0; r < 3; ++r) {
                const float mx = rmax4(a[r]);
                const float delta = mx > THR ? mx : 0.f;
                m[r] += delta; cmo[r] -= delta;
                const float alpha = ex2(-delta);
#pragma unroll
                for (int dt = 0; dt < 5; ++dt) O[r][dt] = O[r][dt] * alpha;
#pragma unroll
                for (int k2 = 0; k2 < 2; ++k2) st[r][k2] = st[r][k2] - delta;
            }
        }
        bf16x8 vf[4];
#pragma unroll
        for (int dt = 0; dt < 4; ++dt) {
            const LAS unsigned char* vrow = Vl + (16 * dt + fr) * KSTR + 8 * (fq & 1);
            const u32x2 v0 = *(const LAS u32x2*)(vrow + (((4 * hf + (fq >> 1)) ^ sw) << 4)), v1 = *(const LAS u32x2*)(vrow + (((4 * hf + 2 + (fq >> 1)) ^ sw) << 4));
            u32x4 w; w.x = v0.x; w.y = v0.y; w.z = v1.x; w.w = v1.y;
            vf[dt] = __builtin_bit_cast(bf16x8, w);
        }
        const unsigned one2 = (fr == 0) ? 0x3f803f80u : 0u;
        const u32x4 w1 = {one2, one2, one2, one2};
        const bf16x8 vone = __builtin_bit_cast(bf16x8, w1);
#pragma unroll
        for (int r = 0; r < 3; ++r) {
#pragma unroll
            for (int k2 = 0; k2 < 2; ++k2)
#pragma unroll
                for (int e = 0; e < 4; ++e) st[r][k2][e] = ex2(st[r][k2][e]);
            u32x4 w; w.x = pk2(st[r][0][0], st[r][0][1]); w.y = pk2(st[r][0][2], st[r][0][3]); w.z = pk2(st[r][1][0], st[r][1][1]); w.w = pk2(st[r][1][2], st[r][1][3]);
            const bf16x8 pb = __builtin_bit_cast(bf16x8, w);
#pragma unroll
            for (int dt = 0; dt < 4; ++dt) O[r][dt] = MFMA16(vf[dt], pb, O[r][dt]);
            O[r][4] = MFMA16(vone, pb, O[r][4]);
        }
    }
}

#define ATT_DMA(buf, kp, vp, vstride) do { \
    __builtin_amdgcn_global_load_lds((const unsigned*)((kp) + lrow * 64 + lchs * 8), (LAS unsigned*)(lds + OFF_K + (buf) * TILE_B + w * 1024), 16, 0, 0); \
    __builtin_amdgcn_global_load_lds((const unsigned*)((vp) + (size_t)lrow * (vstride) + lchs * 8), (LAS unsigned*)(lds + OFF_V + (buf) * TILE_B + w * 1024), 16, 0, 0); } while (0)
#define ATT_WAIT_SYNC() do { asm volatile("s_waitcnt vmcnt(0) lgkmcnt(0)\n\ts_barrier" ::: "memory"); } while (0)
#define ATT_WAIT_SYNC2(more) do { if (more) asm volatile("s_waitcnt vmcnt(2) lgkmcnt(0)\n\ts_barrier" ::: "memory"); else asm volatile("s_waitcnt vmcnt(0) lgkmcnt(0)\n\ts_barrier" ::: "memory"); } while (0)
#define ATT_POP(rem_, j_) do { j_ = 63 - __builtin_clzll(rem_); rem_ &= ~(1ull << j_); } while (0)

__device__ __forceinline__ void attn_item(LAS unsigned char* lds, const P& p, int b, int g, int I) {
    const int tid = my_tid(), lane = tid & 63, w = __builtin_amdgcn_readfirstlane(tid >> 6), fr = lane & 15, fq = lane >> 4;
    const int tq = 128 * I + 16 * w + fr;
    const int iq = 2 * I + (w >> 2);
    const size_t row = (size_t)b * T + tq;
    const int bg = b * 4 + g;
    const int lrow = tid >> 3, lchs = (tid & 7) ^ (lrow & 7);
    LAS float* IMP = (LAS float*)(lds + OFF_IMP);
    LAS unsigned* SELM = (LAS unsigned*)(lds + OFF_SELM);
    LAS unsigned* BUN = (LAS unsigned*)(lds + OFF_BUN);
    for (int i = tid; i < 128 * 65; i += 512) IMP[i] = 0.f;
    if (tid < 2) BUN[tid] = 0u;
    LAS unsigned char* QL = lds + OFF_Q + w * 6144 + lane * 16;
    float sl2[3];
#pragma unroll
    for (int r = 0; r < 3; ++r) {
        const int h = 3 * g + r;
        sl2[r] = (h < 8 ? exp2f(-(float)(h + 1)) : exp2f(-(0.5f + (float)(h - 8)))) * LOG2E;
#pragma unroll
        for (int ks = 0; ks < 2; ++ks) *(LAS bf16x8*)(QL + (r * 2 + ks) * 1024) = *(const bf16x8*)((const bf16*)(p.ws + WS_Q) + row * 768 + h * 64 + 32 * ks + 8 * fq);
    }
    LAS float* gp = (LAS float*)(lds + OFF_Q + 49152) + (16 * w + fr) * 12;
    if (fq < 3) { const float* gsrc = (const float*)(p.ws + WS_G) + row * 36 + 9 * g + 3 * fq; const float g0 = gsrc[0], g1 = gsrc[1], g2 = gsrc[2]; gp[3 * fq] = g0; gp[3 * fq + 1] = g1; gp[3 * fq + 2] = g2; }
    unsigned qaw[3], kaw[4];
#pragma unroll
    for (int r = 0; r < 3; ++r) { const unsigned hi = f2bf(sl2[r]); const unsigned lo = f2bf(sl2[r] - __builtin_bit_cast(float, hi << 16)); qaw[r] = (fq == 0) ? (hi | (lo << 16)) : 0u; }
#pragma unroll
    for (int kt = 0; kt < 4; ++kt) { const unsigned c = f2bf((float)(16 * kt + fr)); kaw[kt] = (fq == 0) ? (c | (c << 16)) : 0u; }
    unsigned qaw16[3];
#pragma unroll
    for (int r = 0; r < 3; ++r) { const float x = 16.0f * sl2[r]; const unsigned hi = f2bf(x); const unsigned lo = f2bf(x - __builtin_bit_cast(float, hi << 16)); qaw16[r] = (fq == 0) ? (hi | (lo << 16)) : 0u; }
    const int tqmin = 128 * I + 16 * w;
    const bf16* KCp = (const bf16*)(p.ws + WS_KC) + (size_t)bg * 256 * 64; const bf16* VCp = (const bf16*)(p.ws + WS_VCT) + (size_t)bg * 64 * 256;
    const int nT = (8 * I + 7 + 63) >> 6;
    const int tqmax = 128 * I + 16 * w + 15;
    float m[3], l[3];
#pragma unroll
    for (int r = 0; r < 3; ++r) { m[r] = M0REF; l[r] = 0.f; }
    for (int t = 0; t < nT; ++t) ATT_DMA(t, KCp + t * 64 * 64, VCp + t * 64, 256);
    ATT_WAIT_SYNC();
    for (int Tt = 0; Tt < nT; ++Tt) {
        if (1024 * Tt + 31 <= tqmax) {
            const LAS unsigned char* Kl = lds + OFF_K + Tt * TILE_B;
            const int crel = 16 * (64 * Tt + 4 * fq) - tq;
            const bool full = 16 * (64 * Tt + 63) + 31 <= tqmin;
            const float cb = (float)(1024 * Tt - tq) + 15.5f;
            float cmo[3];
#pragma unroll
            for (int r = 0; r < 3; ++r) cmo[r] = sl2[r] * cb - m[r];
#pragma unroll 1
            for (int hf = 0; hf < 2; ++hf) {
                f32x4 st[3][2]; qk_half(st, Kl, QL, qaw16, kaw, hf, cmo, fr, fq);
                if (!full) {
#pragma unroll
                    for (int k2 = 0; k2 < 2; ++k2)
#pragma unroll
                        for (int e = 0; e < 4; ++e) { const bool ok = crel + 512 * hf + 256 * k2 + 16 * e + 31 <= 0;
#pragma unroll
                            for (int r = 0; r < 3; ++r) st[r][k2][e] = ok ? st[r][k2][e] : NEG; }
                }
                float a[3];
#pragma unroll
                for (int r = 0; r < 3; ++r) a[r] = max8(st[r]);
                if (__any(fmaxf(fmaxf(a[0], a[1]), a[2]) > 6.0f)) {
#pragma unroll
                    for (int r = 0; r < 3; ++r) {
                        const float mx = rmax4(a[r]);
                        const float delta = mx > 6.0f ? mx : 0.f;
                        m[r] += delta; cmo[r] -= delta; l[r] *= ex2(-delta);
#pragma unroll
                        for (int k2 = 0; k2 < 2; ++k2) st[r][k2] = st[r][k2] - delta;
                    }
                }
#pragma unroll
                for (int r = 0; r < 3; ++r) {
                    float ps = 0.f;
#pragma unroll
                    for (int k2 = 0; k2 < 2; ++k2)
#pragma unroll
                        for (int e = 0; e < 4; ++e) ps += ex2(st[r][k2][e]);
                    l[r] += ps;
                }
            }
        }
    }
    float invl[3];
#pragma unroll
    for (int r = 0; r < 3; ++r) { float s = l[r]; s += __shfl_xor(s, 16); s += __shfl_xor(s, 32); invl[r] = s > 0.f ? -(m[r] + __builtin_amdgcn_logf(s)) : NEG; }
    __syncthreads();
    f32x4 O[3][4];
#pragma unroll
    for (int r = 0; r < 3; ++r)
#pragma unroll
        for (int dt = 0; dt < 4; ++dt) O[r][dt] = (f32x4){0.f, 0.f, 0.f, 0.f};
    for (int Tt = 0; Tt < nT; ++Tt) {
        if (1024 * Tt + 31 <= tqmax) {
            const LAS unsigned char* Kl = lds + OFF_K + Tt * TILE_B; const LAS unsigned char* Vl = lds + OFF_V + Tt * TILE_B;
            const int crel = 16 * (64 * Tt + 4 * fq) - tq;
            const bool full = 16 * (64 * Tt + 63) + 31 <= tqmin;
            const float cb = (float)(1024 * Tt - tq) + 15.5f;
            const int sw = fr & 7;
            float cfin[3];
#pragma unroll
            for (int r = 0; r < 3; ++r) cfin[r] = sl2[r] * cb + invl[r];
#pragma unroll 1
            for (int hf = 0; hf < 2; ++hf) {
                f32x4 st[3][2]; qk_half(st, Kl, QL, qaw16, kaw, hf, cfin, fr, fq);
                float ia[2] = {0.f, 0.f}, ib[2] = {0.f, 0.f};
                bf16x8 vf[4];
#pragma unroll
                for (int dt = 0; dt < 4; ++dt) {
                    const LAS unsigned char* vrow = Vl + (16 * dt + fr) * KSTR + 8 * (fq & 1);
                    const u32x2 v0 = *(const LAS u32x2*)(vrow + (((4 * hf + (fq >> 1)) ^ sw) << 4)), v1 = *(const LAS u32x2*)(vrow + (((4 * hf + 2 + (fq >> 1)) ^ sw) << 4));
                    u32x4 w; w.x = v0.x; w.y = v0.y; w.z = v1.x; w.w = v1.y;
                    vf[dt] = __builtin_bit_cast(bf16x8, w);
                }
#pragma unroll
                for (int r = 0; r < 3; ++r) {
#pragma unroll
                    for (int k2 = 0; k2 < 2; ++k2) {
                        if (full) {
#pragma unroll
                            for (int e = 0; e < 4; ++e) st[r][k2][e] = ex2(st[r][k2][e]);
                        } else {
#pragma unroll
                            for (int e = 0; e < 4; ++e) st[r][k2][e] = (crel + 512 * hf + 256 * k2 + 16 * e + 31 <= 0) ? ex2(st[r][k2][e]) : 0.f;
                        }
                        ia[k2] += (st[r][k2][0] + st[r][k2][1]) + (st[r][k2][2] + st[r][k2][3]); ib[k2] += st[r][k2][3];
                    }
                    u32x4 w; w.x = pk2(st[r][0][0], st[r][0][1]); w.y = pk2(st[r][0][2], st[r][0][3]); w.z = pk2(st[r][1][0], st[r][1][1]); w.w = pk2(st[r][1][2], st[r][1][3]);
                    const bf16x8 pb = __builtin_bit_cast(bf16x8, w);
#pragma unroll
                    for (int dt = 0; dt < 4; ++dt) O[r][dt] = MFMA16(vf[dt], pb, O[r][dt]);
                }
                LAS float* ip = IMP + (16 * w + fr) * 65 + 16 * Tt + 8 * hf + fq;
#pragma unroll
                for (int k2 = 0; k2 < 2; ++k2) {
                    __hip_atomic_fetch_add(ip + 4 * k2, ia[k2], __ATOMIC_RELAXED, __HIP_MEMORY_SCOPE_WORKGROUP);
                    if (16 * Tt + 8 * hf + 4 * k2 + fq + 1 < 64) __hip_atomic_fetch_add(ip + 4 * k2 + 1, ib[k2], __ATOMIC_RELAXED, __HIP_MEMORY_SCOPE_WORKGROUP);
                }
            }
        }
    }
#pragma unroll
    for (int r = 0; r < 3; ++r) { const float gc = gp[3 * r + 0];
#pragma unroll
        for (int dt = 0; dt < 4; ++dt) p.scr[(r * 4 + dt) * 512] = O[r][dt] * gc; }
    __syncthreads();
    {
        const int tok = tid >> 2, qd = tid & 3, cur = iq;
        unsigned long long mask;
        if (cur < 8) mask = (2ull << cur) - 1ull;
        else {
            mask = 1ull | (1ull << cur) | (1ull << (cur - 1));
            float v[16];
#pragma unroll
            for (int jj = 0; jj < 16; ++jj) { const int j = 16 * qd + jj; const float x = IMP[tok * 65 + j]; v[jj] = (j <= cur && j != 0 && j != cur && j != cur - 1) ? x : -1.0f; }
#pragma unroll 1
            for (int rd = 0; rd < 5; ++rd) {
                float bv = v[0]; int bj = 16 * qd;
#pragma unroll
                for (int jj = 1; jj < 16; ++jj) if (v[jj] > bv) { bv = v[jj]; bj = 16 * qd + jj; }
#pragma unroll
                for (int o = 1; o <= 2; o <<= 1) {
                    const int bvb = __builtin_bit_cast(int, bv);
                    const float ov = __builtin_bit_cast(float, o == 1 ? __builtin_amdgcn_update_dpp(bvb, bvb, 0xB1, 0xF, 0xF, true) : __builtin_amdgcn_update_dpp(bvb, bvb, 0x4E, 0xF, 0xF, true));
                    const int oj = o == 1 ? __builtin_amdgcn_update_dpp(bj, bj, 0xB1, 0xF, 0xF, true) : __builtin_amdgcn_update_dpp(bj, bj, 0x4E, 0xF, 0xF, true);
                    if (ov > bv || (ov == bv && oj < bj)) { bv = ov; bj = oj; } }
                if (bv >= 0.f) mask |= 1ull << bj;
#pragma unroll
                for (int jj = 0; jj < 16; ++jj) if (16 * qd + jj == bj) v[jj] = -1.0f;
            }
        }
        if (qd == 0) { SELM[tok * 2] = (unsigned)mask; SELM[tok * 2 + 1] = (unsigned)(mask >> 32); }
    }
    __syncthreads();
    const unsigned selLo = SELM[(16 * w + fr) * 2], selHi = SELM[(16 * w + fr) * 2 + 1];
    unsigned wlo = selLo, whi = selHi;
#pragma unroll
    for (int o = 1; o <= 8; o <<= 1) { wlo |= __shfl_xor(wlo, o); whi |= __shfl_xor(whi, o); }
    wlo = __builtin_amdgcn_readfirstlane(wlo); whi = __builtin_amdgcn_readfirstlane(whi);
    if (lane == 0) { __hip_atomic_fetch_or(BUN, wlo, __ATOMIC_RELAXED, __HIP_MEMORY_SCOPE_WORKGROUP); __hip_atomic_fetch_or(BUN + 1, whi, __ATOMIC_RELAXED, __HIP_MEMORY_SCOPE_WORKGROUP); }
    __syncthreads();
    const unsigned long long bun = (unsigned long long)__builtin_amdgcn_readfirstlane(BUN[0]) | ((unsigned long long)__builtin_amdgcn_readfirstlane(BUN[1]) << 32);
    const unsigned long long wun = (unsigned long long)wlo | ((unsigned long long)whi << 32);
    const unsigned long long selm = (unsigned long long)selLo | ((unsigned long long)selHi << 32);
    f32x4 O5[3][5];
    {
        const bf16* Kp = (const bf16*)(p.ws + WS_KS) + (size_t)bg * T * 64; const bf16* Vp = (const bf16*)(p.ws + WS_VST) + (size_t)bg * 64 * T;
#pragma unroll
        for (int r = 0; r < 3; ++r) { m[r] = M0REF;
#pragma unroll
            for (int dt = 0; dt < 5; ++dt) O5[r][dt] = (f32x4){0.f, 0.f, 0.f, 0.f}; }
        unsigned long long rem = bun; int cur = 0, ja, jb = -1;
        asm volatile("s_waitcnt vmcnt(0)" ::: "memory");
        ATT_POP(rem, ja); ATT_DMA(0, Kp + (size_t)ja * 64 * 64, Vp + ja * 64, T);
        if (rem) { ATT_POP(rem, jb); ATT_DMA(1, Kp + (size_t)jb * 64 * 64, Vp + jb * 64, T); }
        while (ja >= 0) {
            ATT_WAIT_SYNC();
            int na = -1, nb = -1;
            if (rem) { ATT_POP(rem, na); ATT_DMA(cur ^ 2, Kp + (size_t)na * 64 * 64, Vp + na * 64, T); }
            if (rem) { ATT_POP(rem, nb); ATT_DMA((cur ^ 2) + 1, Kp + (size_t)nb * 64 * 64, Vp + nb * 64, T); }
            if ((wun >> ja) & 1ull) {
                const bool selb = ((selm >> ja) & 1ull) != 0ull;
                const bool nm = (ja == iq) || !__all(selb);
                flash_step<0>(lds + OFF_K + cur * TILE_B, lds + OFF_V + cur * TILE_B, QL, qaw, kaw, sl2, 64 * ja + 4 * fq - tq, 64 * ja - tq, selb, nm, m, O5, fr, fq);
            }
            if (jb >= 0 && ((wun >> jb) & 1ull)) {
                const bool selb = ((selm >> jb) & 1ull) != 0ull;
                const bool nm = (jb == iq) || !__all(selb);
                flash_step<0>(lds + OFF_K + (cur + 1) * TILE_B, lds + OFF_V + (cur + 1) * TILE_B, QL, qaw, kaw, sl2, 64 * jb + 4 * fq - tq, 64 * jb - tq, selb, nm, m, O5, fr, fq);
            }
            ja = na; jb = nb; cur ^= 2;
        }
#pragma unroll
        for (int r = 0; r < 3; ++r) { const float s = __shfl(O5[r][4][0], fr); const float sc = gp[3 * r + 1] / s;
#pragma unroll
            for (int dt = 0; dt < 4; ++dt) p.scr[(12 + r * 4 + dt) * 512] = O5[r][dt] * sc; }
    }
    __syncthreads();
    {
        const bf16* Kp = (const bf16*)(p.ws + WS_KW) + (size_t)bg * T * 64; const bf16* Vp = (const bf16*)(p.ws + WS_VWT) + (size_t)bg * 64 * T;
#pragma unroll
        for (int r = 0; r < 3; ++r) { m[r] = M0REF;
#pragma unroll
            for (int dt = 0; dt < 5; ++dt) O5[r][dt] = (f32x4){0.f, 0.f, 0.f, 0.f}; }
        const int jlo = (2 * I - 8) > 0 ? (2 * I - 8) : 0, jhi = 2 * I + 1;
        asm volatile("s_waitcnt vmcnt(0)" ::: "memory");
        ATT_DMA(0, Kp + (size_t)jhi * 64 * 64, Vp + jhi * 64, T);
        if (jhi - 1 >= jlo) ATT_DMA(1, Kp + (size_t)(jhi - 1) * 64 * 64, Vp + (jhi - 1) * 64, T);
        int cur = 0;
        for (int j = jhi; j >= jlo; j -= 2) {
            ATT_WAIT_SYNC();
            if (j - 2 >= jlo) ATT_DMA(cur ^ 2, Kp + (size_t)(j - 2) * 64 * 64, Vp + (j - 2) * 64, T);
            if (j - 3 >= jlo) ATT_DMA((cur ^ 2) + 1, Kp + (size_t)(j - 3) * 64 * 64, Vp + (j - 3) * 64, T);
            if (j >= iq - 8 && j <= iq)
                flash_step<1>(lds + OFF_K + cur * TILE_B, lds + OFF_V + cur * TILE_B, QL, qaw, kaw, sl2, 64 * j + 4 * fq - tq, 64 * j - tq, true, (j == iq) || (j == iq - 8), m, O5, fr, fq);
            const int jj = j - 1;
            if (jj >= jlo && jj >= iq - 8 && jj <= iq)
                flash_step<1>(lds + OFF_K + (cur + 1) * TILE_B, lds + OFF_V + (cur + 1) * TILE_B, QL, qaw, kaw, sl2, 64 * jj + 4 * fq - tq, 64 * jj - tq, true, (jj == iq) || (jj == iq - 8), m, O5, fr, fq);
            cur ^= 2;
        }
#pragma unroll
        for (int r = 0; r < 3; ++r) { const float s = __shfl(O5[r][4][0], fr); const float sc = gp[3 * r + 2] / s;
#pragma unroll
            for (int dt = 0; dt < 4; ++dt) {
                const f32x4 v = (p.scr[(r * 4 + dt) * 512] + p.scr[(12 + r * 4 + dt) * 512]) + O5[r][dt] * sc;
                *(unsigned long long*)((bf16*)(p.ws + WS_XN) + row * D + 256 + (3 * g + r) * 64 + 16 * dt + 4 * fq) = (unsigned long long)pk2(v[0], v[1]) | ((unsigned long long)pk2(v[2], v[3]) << 32);
            } }
    }
    __syncthreads();
}

__device__ __forceinline__ void attn_phase(LAS unsigned char* lds, const P& p, int blk, int G) {
    for (int L = blk; L < 1024; L += G) {
        int bg, I;
        if (G == 256) {
            const int v = L & 255, i = L >> 8, c = v >> 3, s = c & 7, q = c >> 3, ii = (i + q) & 3;
            bg = (v & 7) * 4 + i; I = (ii == 0) ? s : (ii == 1) ? 15 - s : (ii == 2) ? 16 + s : 31 - s; }
        else { bg = L >> 5; I = L & 31; }
        attn_item(lds, p, bg >> 2, bg & 3, I);
    }
}
}
#define XB_TMO      128
#define XB_XCNT(j)  (256  + 64 * (j))
#define XB_XSUB(j)  (1280 + 64 * (j))
#define XB_XGEN(j)  (2304 + 64 * (j))
#define XB_TOP      3328
#define XB_TOPGEN   3392
#define XCD_BAR_WORDS 3456
#define XB_SPIN_CAP (1u << 18)

__device__ __forceinline__ unsigned xb_ld(unsigned* p)              { return __hip_atomic_load(p, __ATOMIC_RELAXED, __HIP_MEMORY_SCOPE_AGENT); }
__device__ __forceinline__ unsigned xb_add(unsigned* p, unsigned v) { return __hip_atomic_fetch_add(p, v, __ATOMIC_RELAXED, __HIP_MEMORY_SCOPE_AGENT); }
__device__ __forceinline__ unsigned xb_xcc_id() { return (unsigned)__builtin_amdgcn_s_getreg((3 << 11) | 20) & 0xFu; }
#define XB_SPIN(cond, bar) do { unsigned _sp = 0; while (cond) { __builtin_amdgcn_s_sleep(1); \
    if ((++_sp & 255u) == 0u) { if (xb_ld(&(bar)[XB_TMO])) break; if (_sp > XB_SPIN_CAP) { atomicAdd(&(bar)[XB_TMO], 1u); break; } } } } while (0)

struct XcdBarrier {
    unsigned* bar; unsigned x;
    volatile LAS unsigned* st;
};

__device__ __forceinline__ XcdBarrier xcd_barrier_post(unsigned* bar, volatile LAS unsigned* st) {
    XcdBarrier b; b.bar = bar; b.x = xb_xcc_id(); b.st = st;
    if (threadIdx.x == 0) (void)xb_add(&bar[XB_XCNT(b.x)], 1u);
    return b;
}
__device__ __forceinline__ void xcd_barrier_complete(unsigned* bar, unsigned x, unsigned& nloc, unsigned& nx) {
    const unsigned G = gridDim.x * gridDim.y * gridDim.z;
    unsigned sum, cnt, mine, sp = 0u;
    for (;;) {
        sum = 0u; cnt = 0u; mine = 0u;
#pragma unroll
        for (unsigned j = 0; j < 16; ++j) { const unsigned c = xb_ld(&bar[XB_XCNT(j)]); sum += c; cnt += (c > 0u) ? 1u : 0u; mine = (j == x) ? c : mine; }
        if (sum == G) break;
        __builtin_amdgcn_s_sleep(1);
        if ((++sp & 255u) == 0u) { if (xb_ld(&bar[XB_TMO])) break; if (sp > XB_SPIN_CAP) { atomicAdd(&bar[XB_TMO], 1u); break; } }
    }
    nloc = mine > 0u ? mine : 1u; nx = cnt > 0u ? cnt : 1u;
}

__device__ __forceinline__ void xcd_barrier(const XcdBarrier& b) {
    asm volatile("s_waitcnt vmcnt(0)" ::: "memory");
    __syncthreads();
    if (threadIdx.x == 0) {
        unsigned* bar = b.bar;
        __builtin_amdgcn_s_waitcnt(0);
        unsigned nloc = b.st[0], nx = b.st[1];
        if (nloc == 0u) { xcd_barrier_complete(bar, b.x, nloc, nx); b.st[0] = nloc; b.st[1] = nx; }
        const unsigned old = xb_add(&bar[XB_XSUB(b.x)], 1u);
        const unsigned gen = old / nloc;
        if (old + 1u == (gen + 1u) * nloc) {
            __builtin_amdgcn_fence(__ATOMIC_RELEASE, "agent");
            asm volatile("s_waitcnt vmcnt(0)" ::: "memory");
            const unsigned og = xb_add(&bar[XB_TOP], 1u);
            const unsigned tg = og / nx;
            if (og + 1u == (tg + 1u) * nx) xb_add(&bar[XB_TOPGEN], 1u);
            else XB_SPIN(xb_ld(&bar[XB_TOPGEN]) == tg, bar);
            __builtin_amdgcn_fence(__ATOMIC_ACQUIRE, "agent");
            xb_add(&bar[XB_XGEN(b.x)], 1u);
            asm volatile("s_waitcnt vmcnt(0)" ::: "memory");
        } else {
            XB_SPIN(xb_ld(&bar[XB_XGEN(b.x)]) == gen, bar);
            __builtin_amdgcn_fence(__ATOMIC_ACQUIRE, "agent");
            asm volatile("s_waitcnt vmcnt(0)" ::: "memory");
        }
    }
    __syncthreads();
}

__global__ void __launch_bounds__(512, 2) hymba_fwd(Args args) {
    extern __shared__ __attribute__((aligned(16))) unsigned char lds_raw[];
    LAS unsigned char* lds = (LAS unsigned char*)lds_raw;
    cg::grid_group grid = cg::this_grid();
    const int G = gridDim.x;
    {
        LAS unsigned long long* ptw = (LAS unsigned long long*)(lds + MISC_OFF + 64);
        if (threadIdx.x == 0) {
#pragma unroll
            for (int i = 0; i < 18; ++i) ptw[i] = (unsigned long long)args.in[i];
            ptw[18] = (unsigned long long)args.out; ptw[19] = (unsigned long long)args.ws;
        }
    }
    const int ph_lo = args.ph_lo, ph_hi = args.ph_hi;
    if (threadIdx.x < 8) ((LAS unsigned*)(lds + MISC_OFF))[threadIdx.x] = 0u;
    __syncthreads();
    XcdBarrier xbar = xcd_barrier_post((unsigned*)(args.ws + WS_CTL), (volatile LAS unsigned*)(lds + MISC_OFF));
    bool first_sync = (ph_lo < 0);
#ifndef USE_CG_SYNC
#define USE_CG_SYNC 0
#endif
#ifndef PROBE_DUP_MASK
#define PROBE_DUP_MASK 0
#endif
#ifndef PROBE_DUP_SYNC
#define PROBE_DUP_SYNC 0
#endif
    for (int ph2 = ph_lo * 2; ph2 < ph_hi * 2; ++ph2) {
        const int ph = ph2 >> 1;
        const int layer = ph / NPH, k = ph % NPH;
        if ((ph2 & 1) && !((PROBE_DUP_MASK >> k & 1) && ph != DEPTH * NPH)) continue;
        int blk = blockIdx.x; asm volatile("" : "+s"(blk));
        PT a; a.t = (LAS const unsigned long long*)(lds + MISC_OFF + 64); a.ap = &args; a.ws = (unsigned char*)a.raw(19);
        unsigned char* ws = a.ws; float* X = (float*)(ws + WS_X); bf16* XN = (bf16*)(ws + WS_XN);
        const float* xin = layer == 0 ? a.in(0) : X;
        unsigned char* wset = ws + WS_WSET + (size_t)(layer & 1) * WSET_BYTES;
        bf16* XB = (bf16*)(ws + WS_XB); float* RSQ1 = (float*)(ws + WS_RSQ); float* RSQ2 = RSQ1 + (size_t)M * 16;
        if (ph != DEPTH * NPH && ((k == 0 && layer > 0) || k == 8)) continue;
        if (ph == DEPTH * NPH) {
            final_rows(XB, RSQ1, a.in(17), (float*)a.raw(18), blk, G);
        } else if (k == 0) {
            prologue_layer(a, 0, lds, blk, G);
            first_rows(xin, XB, RSQ1, blk, G);
        } else if (k == 1) {
            pg8::Gemm g{XB, (const bf16*)(wset + OFF_WIN), M, 2560, D}; pg8::StaticOrder S; S.init(M, 2560, G, blk);
            LAS float* RS = (LAS float*)(lds + 131072); pg8::prep_rstd(S, RSQ1, RS, my_tid());
            pg8::EpiWin E{(bf16*)(ws + WS_ACONV), (bf16*)(ws + WS_Q), (bf16*)(ws + WS_KCR), (bf16*)(ws + WS_VCR), (bf16*)(ws + WS_KS), (bf16*)(ws + WS_KW), (float*)(ws + WS_G), RS};
            pg8::gemm_phase<pg8::EpiWin, pg8::StaticOrder, true, true, false>(lds, g, S, E);
        } else if (k == 2) {
            pg8::Gemm g{XB, (const bf16*)(wset + OFF_WIN) + (size_t)2560 * D, M, 512, D}; pg8::StaticOrder S; S.init(M, 512, G, blk);
            LAS float* RS = (LAS float*)(lds + 131072); pg8::prep_rstd(S, RSQ1, RS, my_tid());
            pg8::EpiVT E{(bf16*)(ws + WS_VST), (bf16*)(ws + WS_VWT), RS};
            pg8::gemm_phase<pg8::EpiVT, pg8::StaticOrder, true, true, true>(lds, g, S, E);
        } else if (k == 3) {
            pg8::Gemm g{(const bf16*)(ws + WS_KCR), (const bf16*)(wset + OFF_CMPW), 16384, 1024, D}; pg8::CmpOrder S{G, blk};
            pg8::EpiCmp E{(float*)(ws + WS_LOHI)};
            pg8::gemm_phase<pg8::EpiCmp, pg8::CmpOrder, true, true, false>(lds, g, S, E);
        } else if (k == 4) {
            conv_phase(a, layer, lds, blk, G);
        } else if (k == 5) {
            cmp2_phase(a, layer, lds, blk, G);
            if (layer + 1 < DEPTH) { __syncthreads(); prologue_layer(a, layer + 1, lds, blk, G); }
        } else if (k == 6) {
            att::P p{ws, (f32x4*)(ws + WS_ASCR) + (size_t)blk * (24 * 512) + my_tid()};
            att::attn_phase(lds, p, blk, G);
        } else if (k == 7) {
            pg8::Gemm g{XN, (const bf16*)(wset + OFF_WOUT), M, D, D}; pg8::StaticOrder S; S.init(M, D, G, blk);
            pg8::EpiRes E{XB, RSQ2};
            pg8::gemm_phase<pg8::EpiRes, pg8::StaticOrder, false, true, false>(lds, g, S, E);
        } else if (k == 9) {
            pg8::Gemm g{XB, (const bf16*)(wset + OFF_WGU), M, 2 * DFF, D}; pg8::StaticOrder S; S.init(M, 2 * DFF, G, blk);
            LAS float* RS = (LAS float*)(lds + 131072); pg8::prep_rstd(S, RSQ2, RS, my_tid());
            pg8::EpiSwiglu E{(bf16*)(ws + WS_HFF), RS};
            pg8::gemm_phase<pg8::EpiSwiglu, pg8::StaticOrder, true, true, false>(lds, g, S, E);
        } else {
            pg8::Gemm g{(const bf16*)(ws + WS_HFF), (const bf16*)(wset + OFF_WD), M, D, DFF}; pg8::StaticOrder S; S.init(M, D, G, blk);
            pg8::EpiRes E{XB, RSQ1};
            pg8::gemm_phase<pg8::EpiRes, pg8::StaticOrder, false, true, false>(lds, g, S, E);
        }
        if (ph2 + 1 < ph_hi * 2) { if ((k == 1 || k == 3) && !(PROBE_DUP_MASK >> k & 1)) __syncthreads(); else { if (first_sync || USE_CG_SYNC) { grid.sync(); first_sync = false; } else xcd_barrier(xbar); if (PROBE_DUP_SYNC) xcd_barrier(xbar); } }
    }
}

#ifndef MULTI_LAUNCH
#define MULTI_LAUNCH 0
#endif
extern "C" void kernel_launch(void* const* d_in, const int* in_sizes, int n_in, void* d_out, int out_size, void* d_ws, size_t ws_size, hipStream_t stream) {
    static int grid = 0;
    if (grid == 0) {
        if (n_in != 18 || out_size != M * D || ws_size < WS_END) { fprintf(stderr, "kernel_launch: unexpected shapes: n_in %d out %d ws %zu (need %zu)\n", n_in, out_size, ws_size, (size_t)WS_END); grid = -1; return; }
        int dev = 0, cus = 0, per_cu = 0;
        (void)hipGetDevice(&dev);
        (void)hipDeviceGetAttribute(&cus, hipDeviceAttributeMultiprocessorCount, dev);
        (void)hipFuncSetAttribute((const void*)hymba_fwd, hipFuncAttributeMaxDynamicSharedMemorySize, LDS_BYTES);
        (void)hipOccupancyMaxActiveBlocksPerMultiprocessor(&per_cu, (const void*)hymba_fwd, 512, LDS_BYTES);
        fprintf(stderr, "kernel_launch: cus %d per_cu %d ws %zu\n", cus, per_cu, ws_size);
        if (per_cu < 1) { fprintf(stderr, "kernel_launch: occupancy query says 0 blocks per CU\n"); per_cu = 1; }
        grid = cus;
        (void)hipGetLastError();
    }
    if (grid < 0) return;
    (void)hipMemsetAsync((char*)d_ws + WS_CTL, 0, CTL_ZERO_BYTES, stream);
    Args a{};
    for (int i = 0; i < 18; ++i) a.in[i] = (const float*)d_in[i];
    a.out = (float*)d_out; a.ws = (unsigned char*)d_ws;
#if MULTI_LAUNCH
    for (int ph = 0; ph < NPHASES; ++ph) { a.ph_lo = ph; a.ph_hi = ph + 1; hipLaunchKernelGGL(hymba_fwd, dim3(grid), dim3(512), LDS_BYTES, stream, a); }
#else
    a.ph_lo = 0; a.ph_hi = NPHASES;
    void* args[] = {&a};
    hipError_t e = hipLaunchCooperativeKernel((const void*)hymba_fwd, dim3(grid), dim3(512), args, LDS_BYTES, stream);
    if (e != hipSuccess) fprintf(stderr, "kernel_launch: cooperative launch failed: %s (grid %d)\n", hipGetErrorString(e), grid);
#endif
}
```
